# Optimizing an MI355X kernel written in HIP

```python
import jax, jax.numpy as jnp
from jax import lax
import numpy as np

D_MODEL = 2048
BATCH = 4
SEQ = 4096
DEPTH = 4

N_MIXERS = 2
HEAD_DIM = 128
N_HEADS = D_MODEL // HEAD_DIM
MOBA_BLOCK = 256
MOBA_TOPK = 3
MOBA_QCHUNK = 16
HGRN_EXPAND = 128
HGRN_HEADS = D_MODEL // HGRN_EXPAND
HGRN_CHUNK = 64
N_GROUPS = 4
EXPERTS_PER_GROUP = 8
N_EXPERTS = N_GROUPS * EXPERTS_PER_GROUP
TOP_E = 2
D_EXPERT = 512
MOE_BLOCK = 128
N_MOBA_LAYERS = (DEPTH + 1) // 2
N_HGRN_LAYERS = DEPTH // 2
DEEPNORM_ALPHA = (2 * DEPTH) ** 0.25
DEEPNORM_BETA = (8 * DEPTH) ** -0.25
LN_EPS = 1e-5
RMS_EPS = 1e-6

kernel_name = "hybrid_moba_hgrn2_hmoe_deepnorm"


def layer_norm(x, g, b):
    xf = x.astype(jnp.float32)
    mu = jnp.mean(xf, axis=-1, keepdims=True)
    var = jnp.mean(jnp.square(xf - mu), axis=-1, keepdims=True)
    return ((xf - mu) * lax.rsqrt(var + LN_EPS) * g.astype(jnp.float32) + b.astype(jnp.float32)).astype(x.dtype)


def moba_attention(x, w_in, w_o):
    B, S, D = x.shape
    q, k, v = jnp.split(x @ w_in, 3, axis=-1)
    heads = lambda t: t.reshape(B, S, N_HEADS, HEAD_DIM).transpose(0, 2, 1, 3)
    q = heads(q) * (HEAD_DIM ** -0.5)
    k, v = heads(k), heads(v)
    nb = -(-S // MOBA_BLOCK)
    pad = nb * MOBA_BLOCK - S
    kp = jnp.pad(k, ((0, 0), (0, 0), (0, pad), (0, 0))).reshape(B, N_HEADS, nb, MOBA_BLOCK, HEAD_DIM)
    vp = jnp.pad(v, ((0, 0), (0, 0), (0, pad), (0, 0))).reshape(B, N_HEADS, nb, MOBA_BLOCK, HEAD_DIM)
    k_mean = jnp.mean(kp.astype(jnp.float32), axis=3).astype(x.dtype)
    gate = jnp.einsum('bhsd,bhnd->bhsn', q, k_mean).astype(jnp.float32)
    q_blk = jnp.arange(S) // MOBA_BLOCK
    fully_past = jnp.arange(nb)[None, :] < q_blk[:, None]
    gate = jnp.where(fully_past, gate, -jnp.inf)
    topk = min(MOBA_TOPK, nb)
    gval, sel = lax.top_k(gate, topk)
    sel_valid = gval > -jnp.inf
    gather_blocks = jax.vmap(jax.vmap(lambda blocks, idx: blocks[idx]))
    n_sel = topk * MOBA_BLOCK

    def chunk(c):
        s0 = c * MOBA_QCHUNK
        qc = lax.dynamic_slice_in_dim(q, s0, MOBA_QCHUNK, axis=2)
        selc = lax.dynamic_slice_in_dim(sel, s0, MOBA_QCHUNK, axis=2)
        validc = lax.dynamic_slice_in_dim(sel_valid, s0, MOBA_QCHUNK, axis=2)
        kg = gather_blocks(kp, selc)
        vg = gather_blocks(vp, selc)
        own = s0 // MOBA_BLOCK
        k_own = lax.dynamic_index_in_dim(kp, own, axis=2, keepdims=False)
        v_own = lax.dynamic_index_in_dim(vp, own, axis=2, keepdims=False)
        s_sel = jnp.einsum('bhqd,bhqnkd->bhqnk', qc, kg).astype(jnp.float32)
        s_sel = jnp.where(validc[..., None], s_sel, -jnp.inf).reshape(B, N_HEADS, MOBA_QCHUNK, n_sel)
        s_own = jnp.einsum('bhqd,bhkd->bhqk', qc, k_own).astype(jnp.float32)
        qpos = s0 + jnp.arange(MOBA_QCHUNK)
        kpos = own * MOBA_BLOCK + jnp.arange(MOBA_BLOCK)
        s_own = jnp.where(kpos[None, :] <= qpos[:, None], s_own, -jnp.inf)
        p = jax.nn.softmax(jnp.concatenate([s_sel, s_own], axis=-1), axis=-1).astype(v.dtype)
        vg = vg.reshape(B, N_HEADS, MOBA_QCHUNK, n_sel, HEAD_DIM)
        return (jnp.einsum('bhqn,bhqnd->bhqd', p[..., :n_sel], vg)
                + jnp.einsum('bhqk,bhkd->bhqd', p[..., n_sel:], v_own))

    o = lax.map(chunk, jnp.arange(S // MOBA_QCHUNK))
    o = o.transpose(1, 2, 0, 3, 4).reshape(B, N_HEADS, S, HEAD_DIM)
    o = o.transpose(0, 2, 1, 3).reshape(B, S, D)
    return o @ w_o


def hgrn2(x, w_in, g_norm, lb, w_o):
    B, S, D = x.shape
    q, f, i, g = jnp.split(x @ w_in, 4, axis=-1)
    q = jax.nn.silu(q.astype(jnp.float32))
    lbf = lb.astype(jnp.float32)
    fg = lbf + (1.0 - lbf) * jax.nn.sigmoid(f.astype(jnp.float32))
    log_f = jnp.log(fg)
    k = 1.0 - fg
    n_chunks = S // HGRN_CHUNK
    to_chunks = lambda t: t.reshape(B, n_chunks, HGRN_CHUNK, HGRN_HEADS, HGRN_EXPAND).transpose(1, 0, 3, 2, 4)
    qc, kc, lc = to_chunks(q), to_chunks(k), to_chunks(log_f)
    ic = i.astype(jnp.float32).reshape(B, n_chunks, HGRN_CHUNK, HGRN_HEADS, HEAD_DIM).transpose(1, 0, 3, 2, 4)
    causal = (jnp.arange(HGRN_CHUNK)[:, None] >= jnp.arange(HGRN_CHUNK)[None, :])[..., None]

    def step(state, inp):
        qb, kb, lb_, ib = inp
        G = jnp.cumsum(lb_, axis=-2)
        o_inter = jnp.einsum('bhck,bhkv->bhcv', qb * jnp.exp(G), state)
        diff = G[:, :, :, None, :] - G[:, :, None, :, :]
        decay = jnp.where(causal, jnp.exp(jnp.where(causal, diff, 0.0)), 0.0)
        A = jnp.einsum('bhtk,bhsk,bhtsk->bhts', qb, kb, decay)
        o_intra = jnp.einsum('bhts,bhsv->bhtv', A, ib)
        G_last = G[:, :, -1:, :]
        state = (jnp.exp(G_last[:, :, 0, :])[..., None] * state
                 + jnp.einsum('bhsk,bhsv->bhkv', kb * jnp.exp(G_last - G), ib))
        return state, o_inter + o_intra

    s0 = jnp.zeros((B, HGRN_HEADS, HGRN_EXPAND, HEAD_DIM), jnp.float32)
    _, o = lax.scan(step, s0, (qc, kc, lc, ic))
    o = o.transpose(1, 0, 3, 2, 4).reshape(B, S, HGRN_HEADS, HEAD_DIM)
    o = o * lax.rsqrt(jnp.mean(jnp.square(o), axis=-1, keepdims=True) + RMS_EPS) * g_norm.astype(jnp.float32)
    o = o.reshape(B, S, D) * jax.nn.silu(g.astype(jnp.float32))
    return o.astype(x.dtype) @ w_o


def hierarchical_moe(x, w_rg, b_rg, w_re, b_re, w_gate, w_up, w_down):
    B, S, D = x.shape
    T = B * S
    xt = x.reshape(T, D)
    pg = jax.nn.softmax((xt @ w_rg).astype(jnp.float32) + b_rg.astype(jnp.float32), axis=-1)
    g_w, g_idx = lax.top_k(pg, 1)
    g_w, g_idx = g_w[:, 0], g_idx[:, 0]
    le_all = jnp.einsum('td,gde->tge', xt, w_re).astype(jnp.float32) + b_re.astype(jnp.float32)
    le = jnp.take_along_axis(le_all, g_idx[:, None, None], axis=1)[:, 0]
    e_w, e_idx = lax.top_k(jax.nn.softmax(le, axis=-1), TOP_E)
    e_w = e_w / jnp.sum(e_w, axis=-1, keepdims=True)
    weights = (g_w[:, None] * e_w).reshape(-1)
    eid = (g_idx[:, None] * EXPERTS_PER_GROUP + e_idx).reshape(-1).astype(jnp.int32)
    tok = jnp.repeat(jnp.arange(T, dtype=jnp.int32), TOP_E)
    n_assign = T * TOP_E
    order = jnp.argsort(eid)
    eid_s, tok_s, w_s = eid[order], tok[order], weights[order]
    counts = jnp.bincount(eid, length=N_EXPERTS)
    starts = jnp.cumsum(counts) - counts
    padded = (counts + MOE_BLOCK - 1) // MOE_BLOCK * MOE_BLOCK
    pends = jnp.cumsum(padded)
    pstarts = pends - padded
    dest = pstarts[eid_s] + (jnp.arange(n_assign) - starts[eid_s])
    n_blk = -(-n_assign // MOE_BLOCK) + N_EXPERTS
    n_rows = n_blk * MOE_BLOCK
    row_tok = jnp.full((n_rows,), T, jnp.int32).at[dest].set(tok_s)
    row_w = jnp.zeros((n_rows,), jnp.float32).at[dest].set(w_s)
    blk_expert = jnp.minimum(jnp.searchsorted(pends, jnp.arange(n_blk) * MOE_BLOCK, side='right'), N_EXPERTS - 1)
    x_pad = jnp.concatenate([xt, jnp.zeros((1, D), xt.dtype)], axis=0)

    def expert_block(args):
        toks, e = args
        xb = x_pad[toks]
        h = jax.nn.silu(xb @ w_gate[e]) * (xb @ w_up[e])
        return h @ w_down[e]

    y_rows = lax.map(expert_block, (row_tok.reshape(n_blk, MOE_BLOCK), blk_expert))
    y_rows = y_rows.reshape(n_rows, D) * row_w[:, None].astype(x.dtype)
    y = jnp.zeros((T + 1, D), x.dtype).at[row_tok].add(y_rows)
    return y[:T].reshape(B, S, D)


def setup_inputs(seed: int = 0) -> dict:
    key = jax.random.key(seed)
    ks = jax.random.split(key, 20)
    nrm = lambda k, shape, s: jax.random.normal(k, shape, jnp.float32) * s
    sd = D_MODEL ** -0.5
    col_scale_moba = jnp.concatenate([jnp.ones((2 * D_MODEL,)), jnp.full((D_MODEL,), DEEPNORM_BETA)]).astype(jnp.float32)
    col_scale_hgrn = jnp.concatenate([jnp.ones((2 * D_MODEL,)), jnp.full((D_MODEL,), DEEPNORM_BETA),
                                      jnp.ones((D_MODEL,))]).astype(jnp.float32)
    return {
        "x": nrm(ks[0], (BATCH, SEQ, D_MODEL), 1.0),
        "moba_w_in": nrm(ks[1], (N_MOBA_LAYERS, D_MODEL, 3 * D_MODEL), sd) * col_scale_moba,
        "moba_w_o": nrm(ks[2], (N_MOBA_LAYERS, D_MODEL, D_MODEL), sd * DEEPNORM_BETA),
        "hgrn_w_in": nrm(ks[3], (N_HGRN_LAYERS, D_MODEL, 4 * D_MODEL), sd) * col_scale_hgrn,
        "hgrn_g_norm": 1.0 + nrm(ks[4], (N_HGRN_LAYERS, HEAD_DIM), 0.02),
        "hgrn_lb_raw": nrm(ks[5], (N_HGRN_LAYERS, D_MODEL), 0.1),
        "hgrn_w_o": nrm(ks[6], (N_HGRN_LAYERS, D_MODEL, D_MODEL), sd * DEEPNORM_BETA),
        "ln_mix_g": 1.0 + nrm(ks[7], (DEPTH, D_MODEL), 0.02),
        "ln_mix_b": nrm(ks[8], (DEPTH, D_MODEL), 0.02),
        "moe_w_rg": nrm(ks[9], (DEPTH, D_MODEL, N_GROUPS), sd),
        "moe_b_rg": nrm(ks[10], (DEPTH, N_GROUPS), 0.01),
        "moe_w_re": nrm(ks[11], (DEPTH, N_GROUPS, D_MODEL, EXPERTS_PER_GROUP), sd),
        "moe_b_re": nrm(ks[12], (DEPTH, N_GROUPS, EXPERTS_PER_GROUP), 0.01),
        "moe_w_gate": nrm(ks[13], (DEPTH, N_EXPERTS, D_MODEL, D_EXPERT), sd),
        "moe_w_up": nrm(ks[14], (DEPTH, N_EXPERTS, D_MODEL, D_EXPERT), sd * DEEPNORM_BETA),
        "moe_w_down": nrm(ks[15], (DEPTH, N_EXPERTS, D_EXPERT, D_MODEL), D_EXPERT ** -0.5 * DEEPNORM_BETA),
        "ln_ffn_g": 1.0 + nrm(ks[16], (DEPTH, D_MODEL), 0.02),
        "ln_ffn_b": nrm(ks[17], (DEPTH, D_MODEL), 0.02),
    }


def reference(x, moba_w_in, moba_w_o, hgrn_w_in, hgrn_g_norm, hgrn_lb_raw, hgrn_w_o, ln_mix_g, ln_mix_b,
              moe_w_rg, moe_b_rg, moe_w_re, moe_b_re, moe_w_gate, moe_w_up, moe_w_down, ln_ffn_g, ln_ffn_b):
    lb_all = jnp.cumsum(jax.nn.softmax(hgrn_lb_raw.astype(jnp.float32), axis=0), axis=0)
    lb_all = lb_all - lb_all[0]
    for layer in range(DEPTH):
        j = layer // N_MIXERS
        if layer % N_MIXERS == 0:
            h = moba_attention(x, moba_w_in[j], moba_w_o[j])
        else:
            h = hgrn2(x, hgrn_w_in[j], hgrn_g_norm[j], lb_all[j], hgrn_w_o[j])
        x = layer_norm(DEEPNORM_ALPHA * x + h, ln_mix_g[layer], ln_mix_b[layer])
        m = hierarchical_moe(x, moe_w_rg[layer], moe_b_rg[layer], moe_w_re[layer], moe_b_re[layer],
                             moe_w_gate[layer], moe_w_up[layer], moe_w_down[layer])
        x = layer_norm(DEEPNORM_ALPHA * x + m, ln_ffn_g[layer], ln_ffn_b[layer])
    return x
```

```cpp
#include <hip/hip_runtime.h>
#include <cstdio>
#include <cstdint>
__device__ __forceinline__ int lane_id() { int l; asm volatile("v_mbcnt_lo_u32_b32 %0, -1, 0\n\tv_mbcnt_hi_u32_b32 %0, -1, %0" : "=v"(l)); return l; }
namespace pg8 {
using ::lane_id;
#define PG8_LAS __attribute__((address_space(3)))
typedef unsigned short bf16_t;
typedef short bf16x8 __attribute__((ext_vector_type(8)));
typedef float f32x4 __attribute__((ext_vector_type(4)));
typedef unsigned u32x4 __attribute__((ext_vector_type(4)));
constexpr int BM = 256, BK = 64, HALF = 128, HTB = HALF * BK * 2  , STAGE_BYTES = 8 * HTB, NXCD = 8, WGM = 8;

__host__ __device__ __forceinline__ int lds_byte(int r, int c) { const int st = (r >> 4) * 2 + (c >> 5), rr = r & 15, cc = c & 31, ob = rr * 64 + cc * 2; return st * 1024 + (ob ^ (((ob >> 9) & 1) << 5)); }
__host__ __device__ __forceinline__ void stage_rc(int b, int& R, int& C) { const int st = b / 1024, sb = b % 1024, swz = sb ^ (((sb >> 9) & 1) << 5); R = (st >> 1) * 16 + swz / 64; C = (st & 1) * 32 + (swz % 64) / 2; }
__host__ __device__ __forceinline__ int perm32(int rho) { const int n = rho >> 4, i = rho & 15; return 8 * (i >> 2) + 4 * n + (i & 3); }

struct Unit { int pm, pn; };

struct StaticOrder {
    const bf16_t* A; const bf16_t* Bt; int K;
    int nM, nN, nwg, G, c;
    __host__ __device__ void init(const bf16_t* A_, const bf16_t* Bt_, int M, int N, int K_, int G_, int c_) { A = A_; Bt = Bt_; K = K_; nM = M / BM; nN = N / BM; nwg = nM * nN; G = G_; c = c_; }
    __device__ __forceinline__ const char* a_ptr(const Unit& u) const { return (const char*)A + (size_t)u.pm * (size_t)(BM * 2) * K; }
    __device__ __forceinline__ const char* b_ptr(const Unit& u) const { return (const char*)Bt + (size_t)u.pn * (size_t)(BM * 2) * K; }
    __host__ __device__ bool next(int i, Unit& u) const {
        const long L = (long)i * G + c; if (L >= nwg) return false;
        int wgid = (int)L; { const int q = nwg / NXCD, r = nwg % NXCD, xcd = wgid % NXCD, off = wgid / NXCD; wgid = (xcd < r ? xcd * (q + 1) : r * (q + 1) + (xcd - r) * q) + off; }
        const int nig = WGM * nN, gid = wgid / nig, fm = gid * WGM, gsz = (nM - fm) < WGM ? (nM - fm) : WGM;
        u.pm = fm + ((wgid % nig) % gsz); u.pn = (wgid % nig) / gsz; return true;
    }
    __device__ __forceinline__ void a_ready(const Unit&) const {}
    __device__ __forceinline__ void done(const Unit&) const {}
};

struct MoeOrder {
    const bf16_t* A; const bf16_t* Bt; int K; int npn; size_t bstride; int ntiles, G, c; const PG8_LAS int* tileExp;
    __device__ __forceinline__ bool next(int i, Unit& u) const { const int L = i * G + c; if (L >= ntiles * npn) return false; u.pm = L / npn; u.pn = L - u.pm * npn; return true; }
    __device__ __forceinline__ const char* a_ptr(const Unit& u) const { return (const char*)A + (size_t)u.pm * (size_t)(BM * 2) * K; }
    __device__ __forceinline__ const char* b_ptr(const Unit& u) const { const int e = __builtin_amdgcn_readfirstlane(tileExp[u.pm]); return (const char*)Bt + (size_t)e * bstride + (size_t)u.pn * (size_t)(BM * 2) * K; }
    __device__ __forceinline__ void a_ready(const Unit&) const {}
    __device__ __forceinline__ void done(const Unit&) const {}
};

__device__ __forceinline__ unsigned cvt_pk_bf16(float lo, float hi) { unsigned r; asm volatile("v_cvt_pk_bf16_f32 %0, %1, %2" : "=v"(r) : "v"(lo), "v"(hi)); return r; }
__device__ __forceinline__ float silu_f(float v) { return v * __builtin_amdgcn_rcpf(1.0f + __expf(-v)); }

struct EpiBf16 {
    static constexpr bool PERM = true, AFTER_DRAIN = false;
    bf16_t* O; int ldc; int split_cols; size_t split_stride;
    __device__ __forceinline__ void operator()(const f32x4 (&acc)[2][2][4][2], const Unit& u, int wr, int wc, int fr, int fq) const {
        const int row0 = u.pm * BM + wr * 64 + fr; int colt = u.pn * BM; bf16_t* base = O;
        if (split_cols) { const int t = colt / split_cols; base += (size_t)t * split_stride; colt -= t * split_cols; }
        const int col0 = colt + wc * 32 + 8 * fq;
#pragma unroll
        for (int ai = 0; ai < 2; ++ai)
#pragma unroll
            for (int m = 0; m < 4; ++m) { bf16_t* rowp = base + (size_t)(row0 + ai * HALF + m * 16) * ldc + col0;
#pragma unroll
                for (int bj = 0; bj < 2; ++bj) { const f32x4 v0 = acc[ai][bj][m][0], v1 = acc[ai][bj][m][1];
                    u32x4 w; w.x = cvt_pk_bf16(v0[0], v0[1]); w.y = cvt_pk_bf16(v0[2], v0[3]); w.z = cvt_pk_bf16(v1[0], v1[1]); w.w = cvt_pk_bf16(v1[2], v1[3]);
                    *(u32x4*)(rowp + bj * HALF) = w; } }
    }
};
struct EpiResF32 {
    static constexpr bool PERM = false, AFTER_DRAIN = false;
    const float* res; float* Y; int ldc; float alpha;
    __device__ __forceinline__ void operator()(const f32x4 (&acc)[2][2][4][2], const Unit& u, int wr, int wc, int fr, int fq) const {
        const int row0 = u.pm * BM + wr * 64 + fr, col0 = u.pn * BM + wc * 32 + 4 * fq;
#pragma unroll
        for (int ai = 0; ai < 2; ++ai)
#pragma unroll
            for (int m = 0; m < 4; ++m) { const size_t off = (size_t)(row0 + ai * HALF + m * 16) * ldc + col0;
#pragma unroll
                for (int bj = 0; bj < 2; ++bj)
#pragma unroll
                    for (int n = 0; n < 2; ++n) { const f32x4 r = *(const f32x4*)(res + off + bj * HALF + n * 16); *(f32x4*)(Y + off + bj * HALF + n * 16) = acc[ai][bj][m][n] + r * alpha; }
                asm volatile("" ::: "memory"); }
    }
};
struct EpiHgrnIn {
    static constexpr bool PERM = true, AFTER_DRAIN = false;
    bf16_t* R; float* LF; const float* lbr0; const float* lbr1; int has_lb; int ldc;
    __device__ __forceinline__ void operator()(const f32x4 (&acc)[2][2][4][2], const Unit& u, int wr, int wc, int fr, int fq) const {
        const int row0 = u.pm * BM + wr * 64 + fr; const int type = u.pn >> 3; const int col0 = (u.pn & 7) * BM + wc * 32 + 8 * fq;
        if (type == 1) {
            f32x4 lb[2][2];
#pragma unroll
            for (int bj = 0; bj < 2; ++bj)
#pragma unroll
                for (int n = 0; n < 2; ++n) {
                    if (has_lb) { const f32x4 r0 = *(const f32x4*)(lbr0 + col0 + bj * HALF + 4 * n), r1 = *(const f32x4*)(lbr1 + col0 + bj * HALF + 4 * n);
#pragma unroll
                        for (int j = 0; j < 4; ++j) lb[bj][n][j] = 1.0f / (1.0f + __expf(r0[j] - r1[j])); }
                    else lb[bj][n] = (f32x4){0.f, 0.f, 0.f, 0.f};
                }
#pragma unroll
            for (int ai = 0; ai < 2; ++ai)
#pragma unroll
                for (int m = 0; m < 4; ++m) { float* rowp = LF + (size_t)(row0 + ai * HALF + m * 16) * ldc + col0;
#pragma unroll
                    for (int bj = 0; bj < 2; ++bj)
#pragma unroll
                        for (int n = 0; n < 2; ++n) { f32x4 o;
#pragma unroll
                            for (int j = 0; j < 4; ++j) { const float sg = 1.0f / (1.0f + __expf(-acc[ai][bj][m][n][j])); const float fg = lb[bj][n][j] + (1.0f - lb[bj][n][j]) * sg; o[j] = __logf(fg); }
                            *(f32x4*)(rowp + bj * HALF + 4 * n) = o; } }
        } else {
            bf16_t* base = (bf16_t*)((char*)R + (type == 0 ? (size_t)0 : ((size_t)(type + 1) << 26)));
#pragma unroll
            for (int ai = 0; ai < 2; ++ai)
#pragma unroll
                for (int m = 0; m < 4; ++m) { bf16_t* rowp = base + (size_t)(row0 + ai * HALF + m * 16) * ldc + col0;
#pragma unroll
                    for (int bj = 0; bj < 2; ++bj) { f32x4 v0 = acc[ai][bj][m][0], v1 = acc[ai][bj][m][1];
                        if (type != 2) {
#pragma unroll
                            for (int j = 0; j < 4; ++j) { v0[j] = silu_f(v0[j]); v1[j] = silu_f(v1[j]); } }
                        u32x4 w; w.x = cvt_pk_bf16(v0[0], v0[1]); w.y = cvt_pk_bf16(v0[2], v0[3]); w.z = cvt_pk_bf16(v1[0], v1[1]); w.w = cvt_pk_bf16(v1[2], v1[3]);
                        *(u32x4*)(rowp + bj * HALF) = w; } }
        }
    }
};
struct EpiMoe1 {
    static constexpr bool PERM = true, AFTER_DRAIN = false;
    bf16_t* Hb; int ldh;
    __device__ __forceinline__ void operator()(const f32x4 (&acc)[2][2][4][2], const Unit& u, int wr, int wc, int fr, int fq) const {
        const int row0 = u.pm * BM + wr * 64 + fr, hid0 = u.pn * 128 + wc * 32 + 8 * fq;
#pragma unroll
        for (int ai = 0; ai < 2; ++ai)
#pragma unroll
            for (int m = 0; m < 4; ++m) { bf16_t* rowp = Hb + (size_t)(row0 + ai * HALF + m * 16) * ldh + hid0;
                f32x4 h0, h1;
#pragma unroll
                for (int j = 0; j < 4; ++j) { h0[j] = silu_f(acc[ai][0][m][0][j]) * acc[ai][0][m][1][j]; h1[j] = silu_f(acc[ai][1][m][0][j]) * acc[ai][1][m][1][j]; }
                u32x4 w; w.x = cvt_pk_bf16(h0[0], h0[1]); w.y = cvt_pk_bf16(h0[2], h0[3]); w.z = cvt_pk_bf16(h1[0], h1[1]); w.w = cvt_pk_bf16(h1[2], h1[3]);
                *(u32x4*)rowp = w; }
    }
};

template <class Epi, class Sched, bool ALIGN_EPI = false, bool SP2 = false>
__device__ __forceinline__ void gemm_phase(PG8_LAS unsigned char* lds, const int K, const Sched& S, const Epi& E, const int wave_id) {
    const int lane_ = lane_id(); const int tid_ = wave_id * 64 + lane_;
    const int tid = tid_, wid = wave_id, lane = lane_, wr = wid >> 2, wc = wid & 3, fr = lane & 15, fq = lane >> 4;
    const int nt = K / BK;
    unsigned voffA[2], voffB[2];
#pragma unroll
    for (int i = 0; i < 2; ++i) { int R, C; stage_rc(tid * 16 + i * 8192, R, C); const int Rb = Epi::PERM ? ((R & ~31) + perm32(R & 31)) : R;
        voffA[i] = (unsigned)(R * K + C) * 2u; voffB[i] = (unsigned)(Rb * K + C) * 2u; }
    const size_t kstep = (size_t)(BK * 2);
    const size_t hstep = (size_t)HALF * K * 2;
    const unsigned ldsw = (unsigned)wid * 1024u;
    const int aoff = lds_byte(wr * 64 + fr, fq * 8), boff = lds_byte(wc * 32 + fr, fq * 8);
#define PG8_SA(b, h) (((b) * 2 + (h)) * HTB)
#define PG8_SB(b, h) ((4 + (b) * 2 + (h)) * HTB)
#define PG8_STAGE(bufoff, gbase, voff) do { _Pragma("unroll") for (int _i = 0; _i < 2; ++_i) \
        __builtin_amdgcn_global_load_lds((const unsigned*)((const char*)(gbase) + (voff)[_i]), (PG8_LAS unsigned*)(lds + (bufoff) + ldsw + _i * 8192), 16, 0, 0); } while (0)
#define PG8_LDA(dst, b, h) do { _Pragma("unroll") for (int m = 0; m < 4; ++m) _Pragma("unroll") for (int k = 0; k < 2; ++k) dst[m][k] = *(const PG8_LAS bf16x8*)(lds + PG8_SA(b, h) + aoff + m * 2048 + k * 1024); } while (0)
#define PG8_LDB(dst, b, h) do { _Pragma("unroll") for (int n = 0; n < 2; ++n) _Pragma("unroll") for (int k = 0; k < 2; ++k) dst[n][k] = *(const PG8_LAS bf16x8*)(lds + PG8_SB(b, h) + boff + n * 2048 + k * 1024); } while (0)
#define PG8_MMA(ai, bj, At, Bt) do { __builtin_amdgcn_s_setprio(1); _Pragma("unroll") for (int m = 0; m < 4; ++m) _Pragma("unroll") for (int n = 0; n < 2; ++n) _Pragma("unroll") for (int k = 0; k < 2; ++k) \
        acc[ai][bj][m][n] = __builtin_amdgcn_mfma_f32_16x16x32_bf16(Bt[n][k], At[m][k], acc[ai][bj][m][n], 0, 0, 0); __builtin_amdgcn_s_setprio(0); } while (0)
#define PG8_WAIT_V(n) asm volatile("s_waitcnt vmcnt(" #n ")" ::: "memory")
#define PG8_WAIT_L(n) asm volatile("s_waitcnt lgkmcnt(" #n ")" ::: "memory")
#define PG8_BAR __builtin_amdgcn_s_barrier()
#define PG8_SCHED __builtin_amdgcn_sched_barrier(0)
    Unit cur, nxt; int ui = 0;
    if (!S.next(0, cur)) return;
    f32x4 acc[2][2][4][2];
#pragma unroll
    for (int a = 0; a < 2; ++a)
#pragma unroll
        for (int b = 0; b < 2; ++b)
#pragma unroll
            for (int m = 0; m < 4; ++m)
#pragma unroll
                for (int n = 0; n < 2; ++n) acc[a][b][m][n] = (f32x4){0.f, 0.f, 0.f, 0.f};
    bf16x8 At[4][2], B0[2][2], B1[2][2];
    const char* cA = S.a_ptr(cur); const char* cB = S.b_ptr(cur);
    S.a_ready(cur);
    if constexpr (SP2) {
        PG8_STAGE(PG8_SB(0, 0), cB, voffB); PG8_STAGE(PG8_SB(0, 1), cB + hstep, voffB); PG8_STAGE(PG8_SA(0, 0), cA, voffA); PG8_STAGE(PG8_SA(0, 1), cA + hstep, voffA);
        if (wr == 1) PG8_BAR;
        PG8_WAIT_V(2); PG8_BAR;
        PG8_STAGE(PG8_SB(1, 0), cB + kstep, voffB); PG8_STAGE(PG8_SA(1, 0), cA + kstep, voffA); PG8_STAGE(PG8_SB(1, 1), cB + hstep + kstep, voffB);
        PG8_WAIT_V(6); PG8_BAR;
    } else {
        PG8_STAGE(PG8_SB(0, 0), cB, voffB); PG8_STAGE(PG8_SA(0, 0), cA, voffA); PG8_STAGE(PG8_SB(0, 1), cB + hstep, voffB); PG8_STAGE(PG8_SA(0, 1), cA + hstep, voffA);
        if (wr == 1) PG8_BAR;
        PG8_WAIT_V(4); PG8_BAR;
        PG8_STAGE(PG8_SB(1, 0), cB + kstep, voffB); PG8_STAGE(PG8_SA(1, 0), cA + kstep, voffA); PG8_STAGE(PG8_SB(1, 1), cB + hstep + kstep, voffB);
        PG8_WAIT_V(6); PG8_BAR;
    }
    for (;;) {
        const bool has_next = S.next(ui + 1, nxt);
        const char* nA = has_next ? S.a_ptr(nxt) : cA; const char* nB = has_next ? S.b_ptr(nxt) : cB;
        for (int t = 0; t < nt; t += 2) {
            const bool last = (t == nt - 2);
            const char* a1 = cA + (size_t)(t + 1) * kstep;
            const char* a2 = last ? nA : cA + (size_t)(t + 2) * kstep; const char* b2 = last ? nB : cB + (size_t)(t + 2) * kstep;
            const char* a3 = a2 + kstep; const char* b3 = b2 + kstep;
            if (last && has_next) S.a_ready(nxt);
            if constexpr (SP2) {
            PG8_LDB(B0, 0, 0); PG8_LDB(B1, 0, 1); PG8_SCHED; PG8_LDA(At, 0, 0); PG8_STAGE(PG8_SA(1, 1), a1 + hstep, voffA);
            PG8_WAIT_V(8); PG8_WAIT_L(0); PG8_BAR; PG8_MMA(0, 0, At, B0); PG8_MMA(0, 1, At, B1); PG8_BAR; PG8_SCHED;
            PG8_LDA(At, 0, 1); PG8_STAGE(PG8_SB(0, 0), b2, voffB); PG8_STAGE(PG8_SB(0, 1), b2 + hstep, voffB); PG8_STAGE(PG8_SA(0, 0), a2, voffA);
            PG8_WAIT_V(8); PG8_WAIT_L(0); PG8_BAR; PG8_MMA(1, 0, At, B0); PG8_MMA(1, 1, At, B1); PG8_BAR; PG8_SCHED;
            PG8_LDB(B0, 1, 0); PG8_LDB(B1, 1, 1); PG8_SCHED; PG8_LDA(At, 1, 0); PG8_STAGE(PG8_SA(0, 1), a2 + hstep, voffA);
            PG8_WAIT_V(8); PG8_WAIT_L(0); PG8_BAR; PG8_MMA(0, 0, At, B0); PG8_MMA(0, 1, At, B1); PG8_BAR; PG8_SCHED;
            PG8_LDA(At, 1, 1); PG8_STAGE(PG8_SB(1, 0), b3, voffB); PG8_STAGE(PG8_SB(1, 1), b3 + hstep, voffB); PG8_STAGE(PG8_SA(1, 0), a3, voffA);
            PG8_WAIT_V(8); PG8_WAIT_L(0); PG8_BAR; PG8_MMA(1, 0, At, B0); PG8_MMA(1, 1, At, B1); PG8_BAR; PG8_SCHED;
            } else {
            PG8_LDB(B0, 0, 0); PG8_SCHED; PG8_LDA(At, 0, 0); PG8_STAGE(PG8_SA(1, 1), a1 + hstep, voffA);
            PG8_WAIT_L(8); PG8_BAR; PG8_WAIT_L(0); PG8_MMA(0, 0, At, B0); PG8_BAR; PG8_SCHED;
            PG8_LDB(B1, 0, 1); PG8_STAGE(PG8_SB(0, 0), b2, voffB);
            PG8_BAR; PG8_WAIT_L(0); PG8_MMA(0, 1, At, B1); PG8_BAR;
            PG8_LDA(At, 0, 1); PG8_STAGE(PG8_SA(0, 0), a2, voffA);
            PG8_BAR; PG8_WAIT_L(0); PG8_MMA(1, 0, At, B0); PG8_BAR; PG8_SCHED;
            PG8_STAGE(PG8_SB(0, 1), b2 + hstep, voffB);
            PG8_WAIT_V(6); PG8_BAR; PG8_MMA(1, 1, At, B1); PG8_BAR;
            PG8_LDB(B0, 1, 0); PG8_SCHED; PG8_LDA(At, 1, 0); PG8_STAGE(PG8_SA(0, 1), a2 + hstep, voffA);
            PG8_WAIT_L(8); PG8_BAR; PG8_WAIT_L(0); PG8_MMA(0, 0, At, B0); PG8_BAR; PG8_SCHED;
            PG8_LDB(B1, 1, 1); PG8_STAGE(PG8_SB(1, 0), b3, voffB);
            PG8_BAR; PG8_WAIT_L(0); PG8_MMA(0, 1, At, B1); PG8_BAR;
            PG8_LDA(At, 1, 1); PG8_STAGE(PG8_SA(1, 0), a3, voffA);
            PG8_BAR; PG8_WAIT_L(0); PG8_MMA(1, 0, At, B0); PG8_BAR; PG8_SCHED;
            PG8_STAGE(PG8_SB(1, 1), b3 + hstep, voffB);
            PG8_WAIT_V(6); PG8_BAR; PG8_MMA(1, 1, At, B1); PG8_BAR;
            }
        }
        if constexpr (ALIGN_EPI) { if (wr == 0) PG8_BAR; }
        if constexpr (!Epi::AFTER_DRAIN) { E(acc, cur, wr, wc, fr, fq); S.done(cur); }
        if (!has_next) break;
#pragma unroll
        for (int a = 0; a < 2; ++a)
#pragma unroll
            for (int b = 0; b < 2; ++b)
#pragma unroll
                for (int m = 0; m < 4; ++m)
#pragma unroll
                    for (int n = 0; n < 2; ++n) acc[a][b][m][n] = (f32x4){0.f, 0.f, 0.f, 0.f};
        cur = nxt; cA = nA; cB = nB; ++ui;
        if constexpr (ALIGN_EPI) { if (wr == 1) PG8_BAR; }
    }
    PG8_WAIT_V(0);
    if constexpr (!ALIGN_EPI) { if (wr == 0) PG8_BAR; }
    PG8_BAR;
    if constexpr (Epi::AFTER_DRAIN) { E.fused(acc, cur, wr, wc, fr, fq, lds, wid, lane); S.done(cur); }
#undef PG8_SA
#undef PG8_SB
#undef PG8_STAGE
#undef PG8_LDA
#undef PG8_LDB
#undef PG8_MMA
#undef PG8_WAIT_V
#undef PG8_WAIT_L
#undef PG8_BAR
#undef PG8_SCHED
}
}

#define GAS __attribute__((address_space(1)))
#define LAS __attribute__((address_space(3)))
typedef unsigned short bf16;
typedef unsigned v4u __attribute__((ext_vector_type(4)));
typedef float f32x4 __attribute__((ext_vector_type(4)));
typedef short bf16x8 __attribute__((ext_vector_type(8)));
typedef GAS unsigned gu32;
typedef GAS unsigned long long gu64;
#define RLX_AGENT __ATOMIC_RELAXED, __HIP_MEMORY_SCOPE_AGENT
#define LDS_WAIT() asm volatile("s_waitcnt lgkmcnt(0)" ::: "memory")
#define VM_WAIT() asm volatile("s_waitcnt vmcnt(0)" ::: "memory")
__device__ __forceinline__ unsigned long long rt() { return __builtin_amdgcn_s_memrealtime(); }
__device__ __forceinline__ unsigned f2bf(float f) { unsigned u = __builtin_bit_cast(unsigned, f); return (u + 0x7fffu + ((u >> 16) & 1u)) >> 16; }
__device__ __forceinline__ unsigned pk2(float lo, float hi) { return f2bf(lo) | (f2bf(hi) << 16); }

#define XB_TMO      128
#define XB_XCNT(j)  (256  + 64 * (j))
#define XB_XSUB(j)  (1280 + 64 * (j))
#define XB_XGEN(j)  (2304 + 64 * (j))
#define XB_TOP      3328
#define XB_TOPGEN   3392
#define XCD_BAR_WORDS 3456
#define XB_SPIN_CAP (1u << 18)

__device__ __forceinline__ unsigned xb_ld(unsigned* p)              { return __hip_atomic_load(p, __ATOMIC_RELAXED, __HIP_MEMORY_SCOPE_AGENT); }
__device__ __forceinline__ unsigned xb_add(unsigned* p, unsigned v) { return __hip_atomic_fetch_add(p, v, __ATOMIC_RELAXED, __HIP_MEMORY_SCOPE_AGENT); }
__device__ __forceinline__ unsigned xb_xcc_id() { return (unsigned)__builtin_amdgcn_s_getreg((3 << 11) | 20) & 0xFu; }
#define XB_SPIN(cond, bar) do { unsigned _sp = 0; while (cond) { __builtin_amdgcn_s_sleep(1); \
    if ((++_sp & 255u) == 0u) { if (xb_ld(&(bar)[XB_TMO])) break; if (_sp > XB_SPIN_CAP) { atomicAdd(&(bar)[XB_TMO], 1u); break; } } } } while (0)

struct XcdBarrier {
    unsigned* bar; unsigned x;
    volatile LAS unsigned* st;
};

__device__ __forceinline__ XcdBarrier xcd_barrier_post(unsigned* bar, volatile LAS unsigned* st, const bool tid0) {
    XcdBarrier b; b.bar = bar; b.x = xb_xcc_id(); b.st = st;
    if (tid0) (void)xb_add(&bar[XB_XCNT(b.x)], 1u);
    return b;
}
__device__ __forceinline__ void xcd_barrier_complete(unsigned* bar, unsigned x, unsigned& nloc, unsigned& nx) {
    const unsigned G = gridDim.x * gridDim.y * gridDim.z;
    unsigned sum, cnt, mine, sp = 0u;
    for (;;) {
        sum = 0u; cnt = 0u; mine = 0u;
#pragma unroll
        for (unsigned j = 0; j < 16; ++j) { const unsigned c = xb_ld(&bar[XB_XCNT(j)]); sum += c; cnt += (c > 0u) ? 1u : 0u; mine = (j == x) ? c : mine; }
        if (sum == G) break;
        __builtin_amdgcn_s_sleep(1);
        if ((++sp & 255u) == 0u) { if (xb_ld(&bar[XB_TMO])) break; if (sp > XB_SPIN_CAP) { atomicAdd(&bar[XB_TMO], 1u); break; } }
    }
    nloc = mine > 0u ? mine : 1u; nx = cnt > 0u ? cnt : 1u;
}

__device__ __forceinline__ void xcd_barrier(const XcdBarrier& b, const int wave_id) {
    const bool tid0 = wave_id == 0 && lane_id() == 0;
    asm volatile("s_waitcnt vmcnt(0)" ::: "memory");
    __syncthreads();
    if (tid0) {
        unsigned* bar = b.bar;
        __builtin_amdgcn_s_waitcnt(0);
        unsigned nloc = b.st[0], nx = b.st[1];
        if (nloc == 0u) { xcd_barrier_complete(bar, b.x, nloc, nx); b.st[0] = nloc; b.st[1] = nx; }
        const unsigned old = xb_add(&bar[XB_XSUB(b.x)], 1u);
        const unsigned gen = old / nloc;
        if (old + 1u == (gen + 1u) * nloc) {
            __builtin_amdgcn_fence(__ATOMIC_RELEASE, "agent");
            asm volatile("s_waitcnt vmcnt(0)" ::: "memory");
            const unsigned og = xb_add(&bar[XB_TOP], 1u);
            const unsigned tg = og / nx;
            if (og + 1u == (tg + 1u) * nx) xb_add(&bar[XB_TOPGEN], 1u);
            else XB_SPIN(xb_ld(&bar[XB_TOPGEN]) == tg, bar);
            __builtin_amdgcn_fence(__ATOMIC_ACQUIRE, "agent");
            xb_add(&bar[XB_XGEN(b.x)], 1u);
            asm volatile("s_waitcnt vmcnt(0)" ::: "memory");
        } else {
            XB_SPIN(xb_ld(&bar[XB_XGEN(b.x)]) == gen, bar);
            __builtin_amdgcn_fence(__ATOMIC_ACQUIRE, "agent");
            asm volatile("s_waitcnt vmcnt(0)" ::: "memory");
        }
    }
    __syncthreads();
}


constexpr int NWAVES = 8, NTHR = 512;
constexpr int BATCH = 4, SEQ = 4096, T = BATCH * SEQ, D = 2048, NH = 16, HD = 128, DEPTH = 4;
constexpr int NQKV = 3 * D, NHIN = 4 * D, NEXP = 32, DEXP = 512, MBLK = 256, NBLK = SEQ / MBLK;
constexpr float ALPHA = 1.6817928305074290f;
constexpr float LN_EPS = 1e-5f, RMS_EPS = 1e-6f;
constexpr float QSCALE = 0.08838834764831845f;
constexpr int MAXTILES = 160;

constexpr size_t MiB = 1u << 20;
constexpr size_t WS_CTL = 0, CTL_ZERO_BYTES = 1 * MiB;
constexpr size_t WS_WQKV = 2 * MiB;
constexpr size_t WS_WOM = 50 * MiB;
constexpr size_t WS_WHIN = 66 * MiB;
constexpr size_t WS_WOH = 130 * MiB;
constexpr size_t WS_W1 = 146 * MiB;
constexpr size_t WS_W2 = 658 * MiB;
constexpr size_t WS_X = 914 * MiB;
constexpr size_t WS_XB = 1042 * MiB;
constexpr size_t WS_Y = 1106 * MiB;
constexpr size_t WS_OB = 1234 * MiB;
constexpr size_t WS_R1 = 1298 * MiB;
constexpr size_t WS_H = 1618 * MiB;
constexpr size_t WS_KM = 1658 * MiB;
constexpr size_t WS_TI = 1659 * MiB;
constexpr size_t WS_END = 1660 * MiB;
constexpr int CW_TMO = 0, CW_CODE = 1, CW_BAR = 4096, CW_CNT = 16384;

constexpr int RING_OFF = 0, RING_BYTES = 131072;
constexpr int LDSCTL_OFF = RING_BYTES, MISC_OFF = LDSCTL_OFF + 320;
constexpr int TAB_OFF = LDSCTL_OFF + 1024;
constexpr int LDS_BYTES = 147456;

struct Frame {
    LAS unsigned char* lds;
    volatile LAS unsigned* MISC;
    gu32* ctl;
    int vcu, G, wave;
    unsigned char* ws;
};

__device__ __forceinline__ float wave_sum(float v) {
#pragma unroll
    for (int o = 1; o < 64; o <<= 1) v += __shfl_xor(v, o);
    return v;
}
__device__ __forceinline__ float bf2f(unsigned short b) { return __builtin_bit_cast(float, (unsigned)b << 16); }
__device__ __forceinline__ float bflo(unsigned w) { return __builtin_bit_cast(float, w << 16); }
__device__ __forceinline__ float bfhi(unsigned w) { return __builtin_bit_cast(float, w & 0xffff0000u); }

template <int MODE>
__device__ __forceinline__ void transpose_item(const float* W, int K, int N, bf16* WT, int par, LAS float* scr, int item, int lane) {
    const int nblk = N / 32, kb = item / nblk, nb = item % nblk, k0 = 64 * kb, n0 = 32 * nb;
#pragma unroll 8
    for (int i = 0; i < 32; ++i) { const int kk = 2 * i + (lane >> 5); scr[kk * 33 + (lane & 31)] = W[(size_t)(k0 + kk) * N + n0 + (lane & 31)]; }
    LDS_WAIT(); asm volatile("" ::: "memory");
    const int c = lane & 7;
#pragma unroll
    for (int j = 0; j < 4; ++j) { const int n = (lane >> 3) + 8 * j; const LAS float* s = scr + (8 * c) * 33 + n;
        v4u o; o.x = pk2(s[0 * 33], s[1 * 33]); o.y = pk2(s[2 * 33], s[3 * 33]); o.z = pk2(s[4 * 33], s[5 * 33]); o.w = pk2(s[6 * 33], s[7 * 33]);
        const int sn = n0 + n;
        const int drow = MODE == 0 ? par + sn : (256 * (sn >> 7) + 128 * ((sn >> 2) & 1) + 32 * ((sn >> 5) & 3) + 8 * ((sn >> 3) & 3) + 4 * par + (sn & 3));
        *(GAS v4u*)(WT + (size_t)drow * K + k0 + 8 * c) = o; }
    LDS_WAIT(); asm volatile("" ::: "memory");
}
__device__ __forceinline__ void p0_prologue(Frame& F, const float* const* in) {
    const int wave = F.wave; int lane = lane_id(); asm volatile("" : "+v"(lane)); const int tid = wave * 64 + lane; (void)tid;

    LAS float* scr = (LAS float*)(F.lds + RING_OFF + wave * 16384);
    const int gw = F.vcu * NWAVES + wave, NGW = F.G * NWAVES;
    constexpr int I_A = (D / 64) * (NQKV / 32), I_B = (D / 64) * (D / 32), I_C = (D / 64) * (NHIN / 32), I_E = (D / 64) * (DEXP / 32);
    constexpr int NITEMS = 2 * I_A + 2 * I_B + 2 * I_C + 2 * I_B + 3 * 128 * I_E;
    bf16* Wqkv = (bf16*)(F.ws + WS_WQKV); bf16* Wom = (bf16*)(F.ws + WS_WOM); bf16* Whin = (bf16*)(F.ws + WS_WHIN); bf16* Woh = (bf16*)(F.ws + WS_WOH);
    bf16* W1 = (bf16*)(F.ws + WS_W1); bf16* W2 = (bf16*)(F.ws + WS_W2);
    for (int it = gw; it < NITEMS; it += NGW) {
        int r = it;
        if (r < 2 * I_A) { const int m = r / I_A; transpose_item<0>(in[1] + (size_t)m * D * NQKV, D, NQKV, Wqkv + (size_t)m * NQKV * D, 0, scr, r - m * I_A, lane); continue; } r -= 2 * I_A;
        if (r < 2 * I_B) { const int m = r / I_B; transpose_item<0>(in[2] + (size_t)m * D * D, D, D, Wom + (size_t)m * D * D, 0, scr, r - m * I_B, lane); continue; } r -= 2 * I_B;
        if (r < 2 * I_C) { const int m = r / I_C; transpose_item<0>(in[3] + (size_t)m * D * NHIN, D, NHIN, Whin + (size_t)m * NHIN * D, 0, scr, r - m * I_C, lane); continue; } r -= 2 * I_C;
        if (r < 2 * I_B) { const int m = r / I_B; transpose_item<0>(in[6] + (size_t)m * D * D, D, D, Woh + (size_t)m * D * D, 0, scr, r - m * I_B, lane); continue; } r -= 2 * I_B;
        if (r < 128 * I_E) { const int m = r / I_E; transpose_item<1>(in[13] + (size_t)m * D * DEXP, D, DEXP, W1 + (size_t)m * 1024 * D, 0, scr, r - m * I_E, lane); continue; } r -= 128 * I_E;
        if (r < 128 * I_E) { const int m = r / I_E; transpose_item<1>(in[14] + (size_t)m * D * DEXP, D, DEXP, W1 + (size_t)m * 1024 * D, 1, scr, r - m * I_E, lane); continue; } r -= 128 * I_E;
        { const int m = r / I_E; transpose_item<0>(in[15] + (size_t)m * DEXP * D, DEXP, D, W2 + (size_t)m * D * DEXP, 0, scr, r - m * I_E, lane); }
    }
    const float* x = in[0]; bf16* XB = (bf16*)(F.ws + WS_XB);
#pragma unroll 1
    for (int m = gw; m < T; m += NGW) {
        const GAS f32x4* xr = (const GAS f32x4*)(x + (size_t)m * D) + lane; GAS unsigned long long* o8 = (GAS unsigned long long*)(XB + (size_t)m * D) + lane;
#pragma unroll
        for (int j = 0; j < 8; ++j) { const f32x4 v = xr[64 * j]; o8[64 * j] = (unsigned long long)pk2(v.x, v.y) | ((unsigned long long)pk2(v.z, v.w) << 32); }
    }
}

__device__ __forceinline__ void kmean_phase(Frame& F) {
    const int wave = F.wave; int lane = lane_id(); asm volatile("" : "+v"(lane)); const int tid = wave * 64 + lane; (void)tid;

    const bf16* KB = (const bf16*)(F.ws + WS_R1 + 64 * MiB); float* KM = (float*)(F.ws + WS_KM);
    for (int it = F.vcu; it < 256; it += F.G) {
        const int bb = it >> 2, quarter = it & 3, b = bb >> 4, blk = bb & 15, col = quarter * 512 + tid;
        const bf16* p = KB + (size_t)(b * SEQ + blk * MBLK) * D + col;
        float s = 0.f;
#pragma unroll 8
        for (int r = 0; r < MBLK; ++r) s += bf2f(p[(size_t)r * D]);
        const int h = col >> 7, d = col & 127;
        KM[((size_t)((b * NH + h) * NBLK + blk)) * HD + d] = s * (1.0f / MBLK);
    }
}

__device__ __forceinline__ void attn_simple_phase(Frame& F) {
    const int wave = F.wave; int lane = lane_id(); asm volatile("" : "+v"(lane)); const int tid = wave * 64 + lane; (void)tid;

    const bf16* QB = (const bf16*)(F.ws + WS_R1); const bf16* KB = QB + (size_t)T * D; const bf16* VB = KB + (size_t)T * D;
    const float* KM = (const float*)(F.ws + WS_KM); bf16* OB = (bf16*)(F.ws + WS_OB);
    LAS unsigned char* Kl = F.lds + RING_OFF; LAS unsigned char* Vl = F.lds + RING_OFF + 65536;
    const int q = tid >> 1, dh = tid & 1;
    for (int u = F.vcu; u < BATCH * NH * NBLK; u += F.G) {
        const int qb = (NBLK - 1) - (u >> 6), bh = u & 63, b = bh >> 4, h = bh & 15;
        const size_t qrow = (size_t)(b * SEQ + qb * MBLK + q);
        float qv[64];
        { const GAS v4u* qp = (const GAS v4u*)(QB + qrow * D + h * HD + dh * 64);
#pragma unroll
          for (int c = 0; c < 8; ++c) { const v4u w = qp[c];
              qv[8 * c + 0] = bflo(w.x) * QSCALE; qv[8 * c + 1] = bfhi(w.x) * QSCALE; qv[8 * c + 2] = bflo(w.y) * QSCALE; qv[8 * c + 3] = bfhi(w.y) * QSCALE;
              qv[8 * c + 4] = bflo(w.z) * QSCALE; qv[8 * c + 5] = bfhi(w.z) * QSCALE; qv[8 * c + 6] = bflo(w.w) * QSCALE; qv[8 * c + 7] = bfhi(w.w) * QSCALE; } }
        float gate[16];
#pragma unroll
        for (int j = 0; j < 16; ++j) {
            float s = -__builtin_inff();
            if (j < qb) { const float* km = KM + ((size_t)(bh * NBLK + j)) * HD + dh * 64; s = 0.f;
#pragma unroll
                for (int d = 0; d < 64; ++d) s += qv[d] * km[d];
                s += __shfl_xor(s, 1); }
            gate[j] = s;
        }
        unsigned sel = 0u;
#pragma unroll
        for (int rep = 0; rep < 3; ++rep) { float best = -__builtin_inff(); int bi = -1;
#pragma unroll
            for (int j = 0; j < 16; ++j) if (!((sel >> j) & 1u) && gate[j] > best) { best = gate[j]; bi = j; }
            if (bi >= 0) sel |= 1u << bi; }
        float mrun = -1e30f, lrun = 0.f; float o[64];
#pragma unroll
        for (int d = 0; d < 64; ++d) o[d] = 0.f;
        for (int j = 0; j <= qb; ++j) {
            __syncthreads();
            { const size_t r0 = (size_t)(b * SEQ + j * MBLK);
#pragma unroll
              for (int c = 0; c < 8; ++c) { const int idx = tid + 512 * c, r = idx >> 4, cc = idx & 15;
                  *(LAS v4u*)(Kl + r * 256 + cc * 16) = *(const GAS v4u*)(KB + (r0 + r) * D + h * HD + cc * 8);
                  *(LAS v4u*)(Vl + r * 256 + cc * 16) = *(const GAS v4u*)(VB + (r0 + r) * D + h * HD + cc * 8); } }
            __syncthreads();
            const bool mine = (j == qb) || ((sel >> j) & 1u);
            const int kend = (j == qb) ? q + 1 : MBLK;
            if (mine) {
#pragma unroll 1
                for (int key = 0; key < kend; ++key) {
                    const LAS v4u* kp = (const LAS v4u*)(Kl + key * 256 + dh * 128); float a = 0.f;
#pragma unroll
                    for (int c = 0; c < 8; ++c) { const v4u w = kp[c];
                        a += qv[8 * c + 0] * bflo(w.x); a += qv[8 * c + 1] * bfhi(w.x); a += qv[8 * c + 2] * bflo(w.y); a += qv[8 * c + 3] * bfhi(w.y);
                        a += qv[8 * c + 4] * bflo(w.z); a += qv[8 * c + 5] * bfhi(w.z); a += qv[8 * c + 6] * bflo(w.w); a += qv[8 * c + 7] * bfhi(w.w); }
                    a += __shfl_xor(a, 1);
                    const float mn = fmaxf(mrun, a), corr = __expf(mrun - mn), p = __expf(a - mn);
                    lrun = lrun * corr + p; mrun = mn;
                    asm volatile("" ::: "memory");
                    const LAS v4u* vp = (const LAS v4u*)(Vl + key * 256 + dh * 128);
#pragma unroll
                    for (int c = 0; c < 8; ++c) { const v4u w = vp[c];
                        o[8 * c + 0] = o[8 * c + 0] * corr + p * bflo(w.x); o[8 * c + 1] = o[8 * c + 1] * corr + p * bfhi(w.x); o[8 * c + 2] = o[8 * c + 2] * corr + p * bflo(w.y); o[8 * c + 3] = o[8 * c + 3] * corr + p * bfhi(w.y);
                        o[8 * c + 4] = o[8 * c + 4] * corr + p * bflo(w.z); o[8 * c + 5] = o[8 * c + 5] * corr + p * bfhi(w.z); o[8 * c + 6] = o[8 * c + 6] * corr + p * bflo(w.w); o[8 * c + 7] = o[8 * c + 7] * corr + p * bfhi(w.w); }
                    asm volatile("" ::: "memory");
                }
            }
        }
        const float inv = 1.0f / lrun;
        { GAS v4u* op = (GAS v4u*)(OB + qrow * D + h * HD + dh * 64);
#pragma unroll
          for (int c = 0; c < 8; ++c) { v4u w; w.x = pk2(o[8 * c + 0] * inv, o[8 * c + 1] * inv); w.y = pk2(o[8 * c + 2] * inv, o[8 * c + 3] * inv); w.z = pk2(o[8 * c + 4] * inv, o[8 * c + 5] * inv); w.w = pk2(o[8 * c + 6] * inv, o[8 * c + 7] * inv); op[c] = w; } }
    }
    __syncthreads();
}

__device__ __forceinline__ void scan_simple_phase(Frame& F) {
    const int wave = F.wave; int lane = lane_id(); asm volatile("" : "+v"(lane)); const int tid = wave * 64 + lane; (void)tid;

    const bf16* QH = (const bf16*)(F.ws + WS_R1); const float* LF = (const float*)(F.ws + WS_R1 + 64 * MiB); const bf16* IH = (const bf16*)(F.ws + WS_R1 + 192 * MiB);
    float* OS = (float*)(F.ws + WS_Y);
    LAS float* qs = (LAS float*)(F.lds + RING_OFF); LAS float* fs = qs + 64 * 128; LAS float* is = fs + 64 * 128; LAS float* red = is + 64 * 32;
    const int k = tid & 127, vq = tid >> 7;
    for (int u = F.vcu; u < BATCH * NH * 4; u += F.G) {
        const int bh = u >> 2, vs = u & 3, b = bh >> 4, h = bh & 15;
        float S[8];
#pragma unroll
        for (int j = 0; j < 8; ++j) S[j] = 0.f;
        for (int c = 0; c < SEQ / 64; ++c) {
            const size_t row0 = (size_t)(b * SEQ + c * 64);
            __syncthreads();
#pragma unroll 4
            for (int r = 0; r < 16; ++r) { const int t = (tid >> 7) + 4 * r; const size_t g = (row0 + t) * D + h * HD + k; qs[t * 128 + k] = bf2f(QH[g]); fs[t * 128 + k] = __expf(LF[g]); }
#pragma unroll
            for (int r = 0; r < 4; ++r) { const int idx = tid + 512 * r, t = idx >> 5, v = idx & 31; is[t * 32 + v] = bf2f(IH[(row0 + t) * D + h * HD + vs * 32 + v]); }
            __syncthreads();
            for (int t = 0; t < 64; ++t) {
                const float fk = fs[t * 128 + k], qk = qs[t * 128 + k], kk = 1.0f - fk;
#pragma unroll
                for (int j = 0; j < 8; ++j) { const float iv = is[t * 32 + vq * 8 + j]; S[j] = fk * S[j] + kk * iv; const float p = wave_sum(qk * S[j]); if (lane == 0) red[(t * 8 + wave) * 8 + j] = p; }
            }
            __syncthreads();
#pragma unroll
            for (int r = 0; r < 4; ++r) { const int idx = tid + 512 * r, t = idx >> 5, v = idx & 31, vq2 = v >> 3, j = v & 7;
                OS[(row0 + t) * D + h * HD + vs * 32 + v] = red[(t * 8 + 2 * vq2) * 8 + j] + red[(t * 8 + 2 * vq2 + 1) * 8 + j]; }
        }
    }
    __syncthreads();
}
__device__ __forceinline__ void gatenorm_phase(Frame& F, const float* gnorm) {
    const int wave = F.wave; int lane = lane_id(); asm volatile("" : "+v"(lane)); const int tid = wave * 64 + lane; (void)tid;

    const float* OS = (const float*)(F.ws + WS_Y); const bf16* GH = (const bf16*)(F.ws + WS_R1 + 256 * MiB); bf16* OB = (bf16*)(F.ws + WS_OB);
    const int gw = F.vcu * NWAVES + wave, NGW = F.G * NWAVES;
    const f32x4 gn = *(const f32x4*)(gnorm + 4 * (lane & 31));
#pragma unroll 1
    for (int m = gw; m < T; m += NGW) {
        const GAS f32x4* orow = (const GAS f32x4*)(OS + (size_t)m * D) + lane; const GAS unsigned long long* grow = (const GAS unsigned long long*)(GH + (size_t)m * D) + lane;
        GAS unsigned long long* o8 = (GAS unsigned long long*)(OB + (size_t)m * D) + lane;
#pragma unroll
        for (int j = 0; j < 8; ++j) { const f32x4 v = orow[64 * j]; const unsigned long long gq = grow[64 * j];
            float ss = (v.x * v.x + v.y * v.y) + (v.z * v.z + v.w * v.w);
#pragma unroll
            for (int o = 1; o < 32; o <<= 1) ss += __shfl_xor(ss, o);
            const float rs = 1.0f / sqrtf(ss * (1.0f / HD) + RMS_EPS);
            const unsigned g0 = (unsigned)gq, g1 = (unsigned)(gq >> 32);
            o8[64 * j] = (unsigned long long)pk2(v.x * rs * gn.x * bflo(g0), v.y * rs * gn.y * bfhi(g0)) | ((unsigned long long)pk2(v.z * rs * gn.z * bflo(g1), v.w * rs * gn.w * bfhi(g1)) << 32); }
    }
}

__device__ __forceinline__ void ln_route_phase(Frame& F, int layer, const float* lng, const float* lnb, const float* wrg, const float* brg, const float* wre, const float* bre) {
    const int wave = F.wave; int lane = lane_id(); asm volatile("" : "+v"(lane)); const int tid = wave * 64 + lane; (void)tid;

    const float* Y = (const float*)(F.ws + WS_Y); float* X = (float*)(F.ws + WS_X); bf16* XB = (bf16*)(F.ws + WS_XB); unsigned* TI = (unsigned*)(F.ws + WS_TI);
    const int gw = F.vcu * NWAVES + wave, NGW = F.G * NWAVES;
#pragma unroll 1
    for (int m = gw; m < T; m += NGW) {
        const GAS f32x4* yr = (const GAS f32x4*)(Y + (size_t)m * D) + lane;
        f32x4 v[8]; float s = 0.f;
#pragma unroll
        for (int j = 0; j < 8; ++j) { v[j] = yr[64 * j]; s += (v[j].x + v[j].y) + (v[j].z + v[j].w); }
        const float mean = wave_sum(s) * (1.0f / D); float s2 = 0.f;
#pragma unroll
        for (int j = 0; j < 8; ++j) { v[j] = v[j] - mean; s2 += (v[j].x * v[j].x + v[j].y * v[j].y) + (v[j].z * v[j].z + v[j].w * v[j].w); }
        const float rstd = 1.0f / sqrtf(wave_sum(s2) * (1.0f / D) + LN_EPS);
        GAS f32x4* xo = (GAS f32x4*)(X + (size_t)m * D) + lane; GAS unsigned long long* o8 = (GAS unsigned long long*)(XB + (size_t)m * D) + lane;
#pragma unroll
        for (int j = 0; j < 8; ++j) { const f32x4 g4 = ((const f32x4*)lng)[lane + 64 * j], b4 = ((const f32x4*)lnb)[lane + 64 * j];
            v[j] = v[j] * rstd * g4 + b4; xo[64 * j] = v[j]; o8[64 * j] = (unsigned long long)pk2(v[j].x, v[j].y) | ((unsigned long long)pk2(v[j].z, v[j].w) << 32); }
        float a0 = 0.f, a1 = 0.f, a2 = 0.f, a3 = 0.f;
#pragma unroll
        for (int j = 0; j < 8; ++j) { const f32x4* wr4 = (const f32x4*)(wrg + (size_t)(4 * lane + 256 * j) * 4);
#pragma unroll
            for (int i = 0; i < 4; ++i) { const f32x4 w = wr4[i]; const float xi = v[j][i]; a0 += xi * w.x; a1 += xi * w.y; a2 += xi * w.z; a3 += xi * w.w; }
            if (j & 1) asm volatile("" ::: "memory"); }
        a0 = wave_sum(a0) + brg[0]; a1 = wave_sum(a1) + brg[1]; a2 = wave_sum(a2) + brg[2]; a3 = wave_sum(a3) + brg[3];
        const float gmx = fmaxf(fmaxf(a0, a1), fmaxf(a2, a3));
        const float e0 = __expf(a0 - gmx), e1 = __expf(a1 - gmx), e2 = __expf(a2 - gmx), e3 = __expf(a3 - gmx);
        const float gs = (e0 + e1) + (e2 + e3);
        const float p0 = e0 / gs, p1 = e1 / gs, p2 = e2 / gs, p3 = e3 / gs;
        int gi = 0; float gwt = p0; if (p1 > gwt) { gwt = p1; gi = 1; } if (p2 > gwt) { gwt = p2; gi = 2; } if (p3 > gwt) { gwt = p3; gi = 3; }
        gi = __builtin_amdgcn_readfirstlane(gi);
        const float* weg = wre + (size_t)gi * D * 8;
        float c[8];
#pragma unroll
        for (int n = 0; n < 8; ++n) c[n] = 0.f;
#pragma unroll
        for (int j = 0; j < 8; ++j) { const f32x4* we4 = (const f32x4*)(weg + (size_t)(4 * lane + 256 * j) * 8);
#pragma unroll
            for (int i = 0; i < 4; ++i) { const f32x4 w0 = we4[2 * i], w1 = we4[2 * i + 1]; const float xi = v[j][i];
                c[0] += xi * w0.x; c[1] += xi * w0.y; c[2] += xi * w0.z; c[3] += xi * w0.w; c[4] += xi * w1.x; c[5] += xi * w1.y; c[6] += xi * w1.z; c[7] += xi * w1.w; }
            asm volatile("" ::: "memory"); }
        float cmx = -__builtin_inff();
#pragma unroll
        for (int n = 0; n < 8; ++n) { c[n] = wave_sum(c[n]) + bre[gi * 8 + n]; cmx = fmaxf(cmx, c[n]); }
        float es = 0.f;
#pragma unroll
        for (int n = 0; n < 8; ++n) { c[n] = __expf(c[n] - cmx); es += c[n]; }
        int i1 = 0; float q1 = -1.f;
#pragma unroll
        for (int n = 0; n < 8; ++n) { c[n] = c[n] / es; if (c[n] > q1) { q1 = c[n]; i1 = n; } }
        int i2 = 0; float q2 = -1.f;
#pragma unroll
        for (int n = 0; n < 8; ++n) if (n != i1 && c[n] > q2) { q2 = c[n]; i2 = n; }
        const float qs = q1 + q2; const float w1 = gwt * (q1 / qs), w2 = gwt * (q2 / qs);
        const int ex1 = gi * 8 + i1, ex2 = gi * 8 + i2;
        if (lane == 0) {
            const unsigned s1 = __hip_atomic_fetch_add(F.ctl + CW_CNT + (layer * 32 + ex1) * 32, 1u, RLX_AGENT);
            const unsigned sl2 = __hip_atomic_fetch_add(F.ctl + CW_CNT + (layer * 32 + ex2) * 32, 1u, RLX_AGENT);
            v4u t0; t0.x = (unsigned)ex1; t0.y = s1; t0.z = __builtin_bit_cast(unsigned, w1); t0.w = 0u;
            v4u t1; t1.x = (unsigned)ex2; t1.y = sl2; t1.z = __builtin_bit_cast(unsigned, w2); t1.w = 0u;
            *(GAS v4u*)(TI + (size_t)m * 8) = t0; *(GAS v4u*)(TI + (size_t)m * 8 + 4) = t1;
        }
    }
}
__device__ __forceinline__ int moe_tables(Frame& F, int layer) {
    const int wave = F.wave; int lane = lane_id(); asm volatile("" : "+v"(lane)); const int tid = wave * 64 + lane; (void)tid;

    volatile LAS int* tab = (volatile LAS int*)(F.lds + TAB_OFF);
    __syncthreads();
    if (tid < 32) tab[tid] = (int)__hip_atomic_load(F.ctl + CW_CNT + (layer * 32 + tid) * 32, RLX_AGENT);
    __syncthreads();
    if (tid == 0) { int base = 0;
        for (int e = 0; e < 32; ++e) { const int nt = (tab[e] + 255) >> 8; tab[32 + e] = base * 256; for (int t = 0; t < nt; ++t) if (base + t < MAXTILES) tab[128 + base + t] = e; base += nt; }
        if (base > MAXTILES) base = MAXTILES;
        tab[64] = base * 256; tab[65] = base; }
    __syncthreads();
    return tab[65];
}
__device__ __forceinline__ void dispatch_phase(Frame& F, int layer) {
    const int wave = F.wave; int lane = lane_id(); asm volatile("" : "+v"(lane)); const int tid = wave * 64 + lane; (void)tid;

    (void)moe_tables(F, layer);
    volatile LAS int* tab = (volatile LAS int*)(F.lds + TAB_OFF);
    const bf16* XB = (const bf16*)(F.ws + WS_XB); bf16* XG = (bf16*)(F.ws + WS_R1); const unsigned* TI = (const unsigned*)(F.ws + WS_TI);
    const int gw = F.vcu * NWAVES + wave, NGW = F.G * NWAVES;
#pragma unroll 1
    for (int m = gw; m < T; m += NGW) {
        const v4u t0 = *(const GAS v4u*)(TI + (size_t)m * 8), t1 = *(const GAS v4u*)(TI + (size_t)m * 8 + 4);
        const int r1 = tab[32 + (int)t0.x] + (int)t0.y, r2 = tab[32 + (int)t1.x] + (int)t1.y;
        const GAS v4u* src = (const GAS v4u*)(XB + (size_t)m * D) + lane; GAS v4u* d1 = (GAS v4u*)(XG + (size_t)r1 * D) + lane; GAS v4u* d2 = (GAS v4u*)(XG + (size_t)r2 * D) + lane;
#pragma unroll
        for (int j = 0; j < 4; ++j) { const v4u w = src[64 * j]; d1[64 * j] = w; d2[64 * j] = w; }
    }
}
__device__ __forceinline__ void ln_ffn_phase(Frame& F, int layer, const float* lng, const float* lnb, float* out_f, bool write_xb) {
    const int wave = F.wave; int lane = lane_id(); asm volatile("" : "+v"(lane)); const int tid = wave * 64 + lane; (void)tid;

    (void)moe_tables(F, layer);
    volatile LAS int* tab = (volatile LAS int*)(F.lds + TAB_OFF);
    const float* X = (const float*)(F.ws + WS_X); bf16* XB = (bf16*)(F.ws + WS_XB); const bf16* YR = (const bf16*)(F.ws + WS_R1 + 160 * MiB); const unsigned* TI = (const unsigned*)(F.ws + WS_TI);
    const int gw = F.vcu * NWAVES + wave, NGW = F.G * NWAVES;
#pragma unroll 1
    for (int m = gw; m < T; m += NGW) {
        const v4u t0 = *(const GAS v4u*)(TI + (size_t)m * 8), t1 = *(const GAS v4u*)(TI + (size_t)m * 8 + 4);
        const int r1 = tab[32 + (int)t0.x] + (int)t0.y, r2 = tab[32 + (int)t1.x] + (int)t1.y;
        const unsigned wz1 = t0.z, wz2 = t1.z; const float w1 = __uint_as_float(wz1), w2 = __uint_as_float(wz2);
        const GAS f32x4* xr = (const GAS f32x4*)(X + (size_t)m * D) + lane;
        const GAS unsigned long long* y1 = (const GAS unsigned long long*)(YR + (size_t)r1 * D) + lane; const GAS unsigned long long* y2 = (const GAS unsigned long long*)(YR + (size_t)r2 * D) + lane;
        f32x4 v[8]; float s = 0.f;
#pragma unroll
        for (int j = 0; j < 8; ++j) { const f32x4 xv = xr[64 * j]; const unsigned long long a = y1[64 * j], bq = y2[64 * j];
            const unsigned a0 = (unsigned)a, a1 = (unsigned)(a >> 32), b0 = (unsigned)bq, b1 = (unsigned)(bq >> 32);
            f32x4 mm; mm.x = w1 * bflo(a0) + w2 * bflo(b0); mm.y = w1 * bfhi(a0) + w2 * bfhi(b0); mm.z = w1 * bflo(a1) + w2 * bflo(b1); mm.w = w1 * bfhi(a1) + w2 * bfhi(b1);
            v[j] = xv * ALPHA + mm; s += (v[j].x + v[j].y) + (v[j].z + v[j].w); }
        const float mean = wave_sum(s) * (1.0f / D); float s2 = 0.f;
#pragma unroll
        for (int j = 0; j < 8; ++j) { v[j] = v[j] - mean; s2 += (v[j].x * v[j].x + v[j].y * v[j].y) + (v[j].z * v[j].z + v[j].w * v[j].w); }
        const float rstd = 1.0f / sqrtf(wave_sum(s2) * (1.0f / D) + LN_EPS);
        GAS f32x4* xo = (GAS f32x4*)(out_f + (size_t)m * D) + lane; GAS unsigned long long* o8 = (GAS unsigned long long*)(XB + (size_t)m * D) + lane;
#pragma unroll
        for (int j = 0; j < 8; ++j) { const f32x4 g4 = ((const f32x4*)lng)[lane + 64 * j], b4 = ((const f32x4*)lnb)[lane + 64 * j];
            v[j] = v[j] * rstd * g4 + b4; xo[64 * j] = v[j]; if (write_xb) o8[64 * j] = (unsigned long long)pk2(v[j].x, v[j].y) | ((unsigned long long)pk2(v[j].z, v[j].w) << 32); }
    }
}

constexpr int PH_PER_LAYER_ = 9;
struct Args { const float* in[18]; float* out; unsigned char* ws; int ph_lo, ph_hi, use_bar, pad; };

constexpr int PH_PER_LAYER = 9, N_PHASES = 1 + DEPTH * PH_PER_LAYER;
#define IN(k) (lo <= (k) && (k) < hi)
#define SEAM(k) do { if ((k) + 1 < hi) xcd_barrier(bar, F.wave); } while (0)
template <int L> __device__ __forceinline__ void run_layer(Frame& F, const Args& args, const XcdBarrier& bar, const int lo, const int hi) {
    const float* const* in = args.in;
    bf16* XB = (bf16*)(F.ws + WS_XB); float* X = (float*)(F.ws + WS_X); float* Y = (float*)(F.ws + WS_Y); bf16* OB = (bf16*)(F.ws + WS_OB);
    bf16* R1 = (bf16*)(F.ws + WS_R1); bf16* HBUF = (bf16*)(F.ws + WS_H);
        constexpr int l = L; constexpr int base = 1 + l * PH_PER_LAYER, jj = l >> 1; constexpr bool hg = (l & 1) != 0;
        if (!(base < hi && lo < base + PH_PER_LAYER)) return;
#ifndef NO_G0
        if (IN(base + 0)) {
#ifndef NO_G0A
            if constexpr (!hg) {
                pg8::StaticOrder S; S.init(XB, (const bf16*)(F.ws + WS_WQKV) + (size_t)jj * NQKV * D, T, NQKV, D, F.G, (int)blockIdx.x);
                pg8::EpiBf16 E{R1, D, D, (size_t)T * D};
                pg8::gemm_phase<pg8::EpiBf16, pg8::StaticOrder, true, true>(F.lds + RING_OFF, D, S, E, F.wave);
            }
#endif
#ifndef NO_G0B
            if constexpr (hg) {
                pg8::StaticOrder S; S.init(XB, (const bf16*)(F.ws + WS_WHIN) + (size_t)jj * NHIN * D, T, NHIN, D, F.G, (int)blockIdx.x);
                pg8::EpiHgrnIn E{R1, (float*)(F.ws + WS_R1 + 64 * MiB), in[5], in[5] + D, jj, D};
                pg8::gemm_phase<pg8::EpiHgrnIn, pg8::StaticOrder, true, true>(F.lds + RING_OFF, D, S, E, F.wave);
            }
#endif
            SEAM(base + 0);
        }
#endif
        if (IN(base + 1)) {
#ifndef NO_KM
 if constexpr (!hg) kmean_phase(F);
#endif
#ifndef NO_SCAN
 if constexpr (hg) scan_simple_phase(F);
#endif
 SEAM(base + 1); }
        if (IN(base + 2)) {
#ifndef NO_ATTN
 if constexpr (!hg) attn_simple_phase(F);
#endif
#ifndef NO_GN
 if constexpr (hg) gatenorm_phase(F, in[4] + (size_t)jj * HD);
#endif
 SEAM(base + 2); }
#ifndef NO_G3
        if (IN(base + 3)) {
            const bf16* Wo = hg ? (const bf16*)(F.ws + WS_WOH) + (size_t)jj * D * D : (const bf16*)(F.ws + WS_WOM) + (size_t)jj * D * D;
            pg8::StaticOrder S; S.init(OB, Wo, T, D, D, F.G, (int)blockIdx.x);
            pg8::EpiResF32 E{l == 0 ? in[0] : (const float*)X, Y, D, ALPHA};
            pg8::gemm_phase<pg8::EpiResF32, pg8::StaticOrder, true, true>(F.lds + RING_OFF, D, S, E, F.wave);
            SEAM(base + 3);
        }
#endif
        #ifndef NO_LNR
        if (IN(base + 4)) { ln_route_phase(F, l, in[7] + (size_t)l * D, in[8] + (size_t)l * D, in[9] + (size_t)l * D * 4, in[10] + l * 4, in[11] + (size_t)l * 4 * D * 8, in[12] + l * 32); SEAM(base + 4); }
#endif
        if (IN(base + 5)) { dispatch_phase(F, l); SEAM(base + 5); }
#ifndef NO_G6
        if (IN(base + 6)) {
            const int ntl = moe_tables(F, l);
            pg8::MoeOrder S{R1, (const bf16*)(F.ws + WS_W1) + (size_t)l * 32 * 1024 * D, D, 4, (size_t)1024 * D * 2, ntl, F.G, F.vcu, (const LAS int*)(F.lds + TAB_OFF) + 128};
            pg8::EpiMoe1 E{HBUF, DEXP};
            pg8::gemm_phase<pg8::EpiMoe1, pg8::MoeOrder, true, true>(F.lds + RING_OFF, D, S, E, F.wave);
            SEAM(base + 6);
        }
#endif
#ifndef NO_G7
        if (IN(base + 7)) {
            const int ntl = moe_tables(F, l);
            pg8::MoeOrder S{HBUF, (const bf16*)(F.ws + WS_W2) + (size_t)l * 32 * D * DEXP, DEXP, 8, (size_t)D * DEXP * 2, ntl, F.G, F.vcu, (const LAS int*)(F.lds + TAB_OFF) + 128};
            pg8::EpiBf16 E{(bf16*)(F.ws + WS_R1 + 160 * MiB), D, 0, 0};
            pg8::gemm_phase<pg8::EpiBf16, pg8::MoeOrder, true, true>(F.lds + RING_OFF, DEXP, S, E, F.wave);
            SEAM(base + 7);
        }
#endif
        #ifndef NO_LNF
        if (IN(base + 8)) { ln_ffn_phase(F, l, in[16] + (size_t)l * D, in[17] + (size_t)l * D, l == DEPTH - 1 ? args.out : X, l != DEPTH - 1); SEAM(base + 8); }
#endif
    }
__global__ void __launch_bounds__(NTHR, 2) mk_fwd(Args args) {
    extern __shared__ __attribute__((aligned(16))) unsigned char lds[];
    Frame F;
    F.lds = (LAS unsigned char*)lds;
    F.MISC = (volatile LAS unsigned*)(F.lds + MISC_OFF);
    F.wave = __builtin_amdgcn_readfirstlane((int)(threadIdx.x >> 6));
    F.G = gridDim.x; { const int bx = blockIdx.x; F.vcu = (F.G % 8 == 0) ? (bx % 8) * (F.G / 8) + bx / 8 : bx; }
    F.ws = args.ws; F.ctl = (gu32*)(args.ws + WS_CTL);
    for (int u = F.wave * 64 + lane_id(); u < (LDS_BYTES - LDSCTL_OFF) / 4; u += NTHR) ((LAS unsigned*)(F.lds + LDSCTL_OFF))[u] = 0u;
    __syncthreads();
    XcdBarrier bar; bar.bar = (unsigned*)(F.ctl + CW_BAR); bar.x = 0; bar.st = nullptr;
    if (args.use_bar) bar = xcd_barrier_post((unsigned*)(F.ctl + CW_BAR), F.MISC + 8, F.wave == 0 && lane_id() == 0);
    const int lo = args.ph_lo, hi = args.ph_hi;
    const float* const* in = args.in;
    bf16* XB = (bf16*)(F.ws + WS_XB); float* X = (float*)(F.ws + WS_X); float* Y = (float*)(F.ws + WS_Y); bf16* OB = (bf16*)(F.ws + WS_OB);
    bf16* R1 = (bf16*)(F.ws + WS_R1); bf16* HBUF = (bf16*)(F.ws + WS_H);

    #ifndef NO_P0
    if (IN(0)) { p0_prologue(F, in); SEAM(0); }
#endif

    run_layer<0>(F, args, bar, lo, hi); run_layer<1>(F, args, bar, lo, hi); run_layer<2>(F, args, bar, lo, hi); run_layer<3>(F, args, bar, lo, hi);
#undef IN
#undef SEAM
}

#ifndef MK_N_LAUNCHES
#define MK_N_LAUNCHES 0
#endif
extern "C" void kernel_launch(void* const* d_in, const int* in_sizes, int n_in, void* d_out, int out_size, void* d_ws, size_t ws_size, hipStream_t stream) {
    static int grid = 0;
    if (grid == 0) {
        if (n_in != 18 || in_sizes[0] != T * D || out_size != T * D || ws_size < WS_END) { fprintf(stderr, "kernel_launch: unexpected shapes (n_in %d, in0 %d, out %d, ws %zu); nothing launched\n", n_in, n_in > 0 ? in_sizes[0] : -1, out_size, ws_size); grid = -1; return; }
        int dev = 0, cus = 0, per_cu = 0;
        if (hipGetDevice(&dev) != hipSuccess || hipDeviceGetAttribute(&cus, hipDeviceAttributeMultiprocessorCount, dev) != hipSuccess) { fprintf(stderr, "kernel_launch: device query failed\n"); grid = -1; return; }
        if (hipFuncSetAttribute((const void*)mk_fwd, hipFuncAttributeMaxDynamicSharedMemorySize, LDS_BYTES) != hipSuccess) { fprintf(stderr, "kernel_launch: hipFuncSetAttribute failed\n"); grid = -1; return; }
        if (hipOccupancyMaxActiveBlocksPerMultiprocessor(&per_cu, (const void*)mk_fwd, NTHR, LDS_BYTES) != hipSuccess || per_cu < 1) fprintf(stderr, "kernel_launch: occupancy query reports %d\n", per_cu);
        (void)hipGetLastError();
        grid = cus;
    }
    if (grid < 0) return;
    if (hipMemsetAsync((char*)d_ws + WS_CTL, 0, CTL_ZERO_BYTES, stream) != hipSuccess) { fprintf(stderr, "kernel_launch: memset failed\n"); return; }
    Args a{};
    for (int i = 0; i < 18; ++i) a.in[i] = (const float*)d_in[i];
    a.out = (float*)d_out; a.ws = (unsigned char*)d_ws; a.pad = 0;
#if MK_N_LAUNCHES == 1
    a.ph_lo = 0; a.ph_hi = N_PHASES; a.use_bar = 1;
    hipLaunchKernelGGL(mk_fwd, dim3(grid), dim3(NTHR), LDS_BYTES, stream, a);
#else
    for (int p = 0; p < N_PHASES; ++p) { a.ph_lo = p; a.ph_hi = p + 1; a.use_bar = 0; hipLaunchKernelGGL(mk_fwd, dim3(grid), dim3(NTHR), LDS_BYTES, stream, a); }
#endif
    const hipError_t le = hipPeekAtLastError();
    if (le != hipSuccess) fprintf(stderr, "kernel_launch: launch failed: %s\n", hipGetErrorName(le));
}
```

```cpp
#include <hip/hip_runtime.h>
#include <cstdio>
#include <cstdint>
__device__ __forceinline__ int lane_id() { int l; asm volatile("v_mbcnt_lo_u32_b32 %0, -1, 0\n\tv_mbcnt_hi_u32_b32 %0, -1, %0" : "=v"(l)); return l; }
namespace pg8 {
using ::lane_id;
#define PG8_LAS __attribute__((address_space(3)))
typedef unsigned short bf16_t;
typedef short bf16x8 __attribute__((ext_vector_type(8)));
typedef float f32x4 __attribute__((ext_vector_type(4)));
typedef unsigned u32x4 __attribute__((ext_vector_type(4)));
typedef int i32x4 __attribute__((ext_vector_type(4)));
typedef int i32x8 __attribute__((ext_vector_type(8)));
constexpr int BM = 256, BK = 64, HALF = 128, HTB = HALF * BK * 2  , STAGE_BYTES = 8 * HTB, NXCD = 8, WGM = 8;

__host__ __device__ __forceinline__ int lds_byte(int r, int c) { const int st = (r >> 4) * 2 + (c >> 5), rr = r & 15, cc = c & 31, ob = rr * 64 + cc * 2; return st * 1024 + (ob ^ (((ob >> 9) & 1) << 5)); }
__host__ __device__ __forceinline__ void stage_rc(int b, int& R, int& C) { const int st = b / 1024, sb = b % 1024, swz = sb ^ (((sb >> 9) & 1) << 5); R = (st >> 1) * 16 + swz / 64; C = (st & 1) * 32 + (swz % 64) / 2; }
__host__ __device__ __forceinline__ int perm32(int rho) { const int n = rho >> 4, i = rho & 15; return 8 * (i >> 2) + 4 * n + (i & 3); }

struct Unit { int pm, pn; };

struct StaticOrder {
    const bf16_t* A; const bf16_t* Bt; int K;
    int nM, nN, nwg, G, c;
    __host__ __device__ void init(const bf16_t* A_, const bf16_t* Bt_, int M, int N, int K_, int G_, int c_) { A = A_; Bt = Bt_; K = K_; nM = M / BM; nN = N / BM; nwg = nM * nN; G = G_; c = c_; }
    __device__ __forceinline__ const char* a_ptr(const Unit& u) const { return (const char*)A + (size_t)u.pm * (size_t)(BM * 2) * K; }
    __device__ __forceinline__ const char* b_ptr(const Unit& u) const { return (const char*)Bt + (size_t)u.pn * (size_t)(BM * 2) * K; }
    __host__ __device__ bool next(int i, Unit& u) const {
        const long L = (long)i * G + c; if (L >= nwg) return false;
        int wgid = (int)L; { const int q = nwg / NXCD, r = nwg % NXCD, xcd = wgid % NXCD, off = wgid / NXCD; wgid = (xcd < r ? xcd * (q + 1) : r * (q + 1) + (xcd - r) * q) + off; }
        const int nig = WGM * nN, gid = wgid / nig, fm = gid * WGM, gsz = (nM - fm) < WGM ? (nM - fm) : WGM;
        u.pm = fm + ((wgid % nig) % gsz); u.pn = (wgid % nig) / gsz; return true;
    }
    __device__ __forceinline__ void a_ready(const Unit&) const {}
    __device__ __forceinline__ void done(const Unit&) const {}
};

struct MoeOrder {
    const bf16_t* A; const bf16_t* Bt; int K; int npn; size_t bstride; int ntiles, G, c; const PG8_LAS int* tileExp;
    __device__ __forceinline__ bool next(int i, Unit& u) const { const int L = i * G + c; if (L >= ntiles * npn) return false; u.pm = L / npn; u.pn = L - u.pm * npn; return true; }
    __device__ __forceinline__ const char* a_ptr(const Unit& u) const { return (const char*)A + (size_t)u.pm * (size_t)(BM * 2) * K; }
    __device__ __forceinline__ const char* b_ptr(const Unit& u) const { const int e = __builtin_amdgcn_readfirstlane(tileExp[u.pm]); return (const char*)Bt + (size_t)e * bstride + (size_t)u.pn * (size_t)(BM * 2) * K; }
    __device__ __forceinline__ void a_ready(const Unit&) const {}
    __device__ __forceinline__ void done(const Unit&) const {}
};

__device__ __forceinline__ unsigned cvt_pk_bf16(float lo, float hi) { unsigned r; asm volatile("v_cvt_pk_bf16_f32 %0, %1, %2" : "=v"(r) : "v"(lo), "v"(hi)); return r; }
__device__ __forceinline__ float silu_f(float v) { return v * __builtin_amdgcn_rcpf(1.0f + __expf(-v)); }

struct EpiBf16 {
    static constexpr bool PERM = true, AFTER_DRAIN = false;
    bf16_t* O; int ldc; int split_cols; size_t split_stride; float scale; float* ksum;
    __device__ __forceinline__ void operator()(const f32x4 (&acc)[2][2][4][2], const Unit& u, int wr, int wc, int fr, int fq) const {
        int row0 = u.pm * BM + wr * 64 + fr; asm volatile("" : "+v"(row0));
        int colt = u.pn * BM; bf16_t* base = O;
        if (split_cols) { const int t = colt / split_cols; base += (size_t)t * split_stride; colt -= t * split_cols; }
        const int col0 = colt + wc * 32 + 8 * fq;
#pragma unroll
        for (int ai = 0; ai < 2; ++ai)
#pragma unroll
            for (int m = 0; m < 4; ++m) { bf16_t* rowp = base + (size_t)(row0 + ai * HALF + m * 16) * ldc + col0;
#pragma unroll
                for (int bj = 0; bj < 2; ++bj) { const f32x4 v0 = acc[ai][bj][m][0] * scale, v1 = acc[ai][bj][m][1] * scale;
                    u32x4 w; w.x = cvt_pk_bf16(v0[0], v0[1]); w.y = cvt_pk_bf16(v0[2], v0[3]); w.z = cvt_pk_bf16(v1[0], v1[1]); w.w = cvt_pk_bf16(v1[2], v1[3]);
                    *(u32x4*)(rowp + bj * HALF) = w; } }
        if (ksum != nullptr && split_cols != 0 && (u.pn * BM) / split_cols == 1) {
            const int colk0 = u.pn * BM - split_cols + wc * 32 + 8 * ((lane_id() >> 4) & 3);
#pragma unroll
            for (int bj = 0; bj < 2; ++bj)
#pragma unroll
                for (int n = 0; n < 2; ++n)
#pragma unroll
                    for (int j = 0; j < 4; ++j) { float cs = 0.f;
#pragma unroll
                        for (int ai = 0; ai < 2; ++ai)
#pragma unroll
                            for (int m = 0; m < 4; ++m) cs += acc[ai][bj][m][n][j];
                        cs += __shfl_xor(cs, 1); cs += __shfl_xor(cs, 2); cs += __shfl_xor(cs, 4); cs += __shfl_xor(cs, 8);
                        const int col = colk0 + bj * HALF + 4 * n + j;
                        if ((lane_id() & 15) == 0) atomicAdd(ksum + ((size_t)(((u.pm >> 4) * 16 + (col >> 7)) * 16 + (u.pm & 15))) * 128 + (col & 127), cs * scale); }
        }
    }
};
struct EpiF8 {
    static constexpr bool PERM = true, AFTER_DRAIN = false;
    unsigned char* O; int ldc; float scale;
    __device__ __forceinline__ void operator()(const f32x4 (&acc)[2][2][4][2], const Unit& u, int wr, int wc, int fr, int fq) const {
        int row0 = u.pm * BM + wr * 64 + fr; asm volatile("" : "+v"(row0)); const int col0 = u.pn * BM + wc * 32 + 8 * fq;
#pragma unroll
        for (int ai = 0; ai < 2; ++ai)
#pragma unroll
            for (int m = 0; m < 4; ++m) { unsigned char* rowp = O + (size_t)(row0 + ai * HALF + m * 16) * ldc + col0;
#pragma unroll
                for (int bj = 0; bj < 2; ++bj) { f32x4 v0 = acc[ai][bj][m][0] * scale, v1 = acc[ai][bj][m][1] * scale;
#pragma unroll
                    for (int j = 0; j < 4; ++j) { v0[j] = __builtin_amdgcn_fmed3f(v0[j], -448.f, 448.f); v1[j] = __builtin_amdgcn_fmed3f(v1[j], -448.f, 448.f); }
                    int w0 = __builtin_amdgcn_cvt_pk_fp8_f32(v0[0], v0[1], 0, false); w0 = __builtin_amdgcn_cvt_pk_fp8_f32(v0[2], v0[3], w0, true);
                    int w1 = __builtin_amdgcn_cvt_pk_fp8_f32(v1[0], v1[1], 0, false); w1 = __builtin_amdgcn_cvt_pk_fp8_f32(v1[2], v1[3], w1, true);
                    typedef int i32x2_ __attribute__((ext_vector_type(2)));
                    *(i32x2_*)(rowp + bj * HALF) = (i32x2_){w0, w1}; } }
    }
};
struct EpiResB16 {
    static constexpr bool PERM = true, AFTER_DRAIN = false;
    const float* res; const bf16_t* rhi; const bf16_t* rlo; bf16_t* Y; int ldc; float alpha, scale;
    __device__ __forceinline__ void operator()(const f32x4 (&acc)[2][2][4][2], const Unit& u, int wr, int wc, int fr, int fq) const {
        int row0 = u.pm * BM + wr * 64 + fr; asm volatile("" : "+v"(row0)); const int col0 = u.pn * BM + wc * 32 + 8 * fq;
#pragma unroll
        for (int ai = 0; ai < 2; ++ai)
#pragma unroll
            for (int m = 0; m < 4; ++m) { const size_t off = (size_t)(row0 + ai * HALF + m * 16) * ldc + col0;
#pragma unroll
                for (int bj = 0; bj < 2; ++bj) { f32x4 r0, r1;
                    if (res) { r0 = *(const f32x4*)(res + off + bj * HALF); r1 = *(const f32x4*)(res + off + bj * HALF + 4); }
                    else { const u32x4 h = *(const u32x4*)(rhi + off + bj * HALF), lw = *(const u32x4*)(rlo + off + bj * HALF);
                        r0 = (f32x4){__uint_as_float(h.x << 16) + __uint_as_float(lw.x << 16), __uint_as_float(h.x & 0xffff0000u) + __uint_as_float(lw.x & 0xffff0000u), __uint_as_float(h.y << 16) + __uint_as_float(lw.y << 16), __uint_as_float(h.y & 0xffff0000u) + __uint_as_float(lw.y & 0xffff0000u)};
                        r1 = (f32x4){__uint_as_float(h.z << 16) + __uint_as_float(lw.z << 16), __uint_as_float(h.z & 0xffff0000u) + __uint_as_float(lw.z & 0xffff0000u), __uint_as_float(h.w << 16) + __uint_as_float(lw.w << 16), __uint_as_float(h.w & 0xffff0000u) + __uint_as_float(lw.w & 0xffff0000u)}; }
                    const f32x4 o0 = acc[ai][bj][m][0] * scale + r0 * alpha, o1 = acc[ai][bj][m][1] * scale + r1 * alpha;
                    u32x4 w; w.x = cvt_pk_bf16(o0[0], o0[1]); w.y = cvt_pk_bf16(o0[2], o0[3]); w.z = cvt_pk_bf16(o1[0], o1[1]); w.w = cvt_pk_bf16(o1[2], o1[3]);
                    *(u32x4*)(Y + off + bj * HALF) = w; }
                asm volatile("" ::: "memory"); }
    }
};
struct EpiHgrnIn {
    static constexpr bool PERM = true, AFTER_DRAIN = false;
    bf16_t* R; float* LF; bf16_t* KK; const float* lbr0; const float* lbr1; int has_lb; int ldc;
    __device__ __forceinline__ void operator()(const f32x4 (&acc)[2][2][4][2], const Unit& u, int wr, int wc, int fr, int fq) const {
        const int row0 = u.pm * BM + wr * 64 + fr; const int type = u.pn >> 3; const int col0 = (u.pn & 7) * BM + wc * 32 + 8 * fq;
        if (type == 1) {
            f32x4 lb[2][2];
#pragma unroll
            for (int bj = 0; bj < 2; ++bj)
#pragma unroll
                for (int n = 0; n < 2; ++n) {
                    if (has_lb) { const f32x4 r0 = *(const f32x4*)(lbr0 + col0 + bj * HALF + 4 * n), r1 = *(const f32x4*)(lbr1 + col0 + bj * HALF + 4 * n);
#pragma unroll
                        for (int j = 0; j < 4; ++j) lb[bj][n][j] = 1.0f / (1.0f + __expf(r0[j] - r1[j])); }
                    else lb[bj][n] = (f32x4){0.f, 0.f, 0.f, 0.f};
                }
#pragma unroll
            for (int ai = 0; ai < 2; ++ai)
#pragma unroll
                for (int m = 0; m < 4; ++m) { float* rowp = LF + (size_t)(row0 + ai * HALF + m * 16) * ldc + col0; bf16_t* kkp = KK + (size_t)(row0 + ai * HALF + m * 16) * ldc + col0;
#pragma unroll
                    for (int bj = 0; bj < 2; ++bj)
#pragma unroll
                        for (int n = 0; n < 2; ++n) { f32x4 o, kq;
#pragma unroll
                            for (int j = 0; j < 4; ++j) { const float sg = __builtin_amdgcn_rcpf(1.0f + __expf(-acc[ai][bj][m][n][j])); const float fg = lb[bj][n][j] + (1.0f - lb[bj][n][j]) * sg; o[j] = __builtin_amdgcn_logf(fg); kq[j] = 1.0f - fg; }
                            *(f32x4*)(rowp + bj * HALF + 4 * n) = o;
                            typedef unsigned u32x2_ __attribute__((ext_vector_type(2)));
                            *(u32x2_*)(kkp + bj * HALF + 4 * n) = (u32x2_){cvt_pk_bf16(kq[0], kq[1]), cvt_pk_bf16(kq[2], kq[3])}; } }
        } else {
            bf16_t* base = (bf16_t*)((char*)R + (type == 0 ? (size_t)0 : ((size_t)(type + 1) << 26)));
#pragma unroll
            for (int ai = 0; ai < 2; ++ai)
#pragma unroll
                for (int m = 0; m < 4; ++m) { bf16_t* rowp = base + (size_t)(row0 + ai * HALF + m * 16) * ldc + col0;
#pragma unroll
                    for (int bj = 0; bj < 2; ++bj) { f32x4 v0 = acc[ai][bj][m][0], v1 = acc[ai][bj][m][1];
                        if (type != 2) {
#pragma unroll
                            for (int j = 0; j < 4; ++j) { v0[j] = silu_f(v0[j]); v1[j] = silu_f(v1[j]); } }
                        u32x4 w; w.x = cvt_pk_bf16(v0[0], v0[1]); w.y = cvt_pk_bf16(v0[2], v0[3]); w.z = cvt_pk_bf16(v1[0], v1[1]); w.w = cvt_pk_bf16(v1[2], v1[3]);
                        *(u32x4*)(rowp + bj * HALF) = w; } }
        }
    }
};
struct EpiMoe1 {
    static constexpr bool PERM = true, AFTER_DRAIN = false;
    unsigned char* Hb; int ldh; float hscale, ascale;
    __device__ __forceinline__ void operator()(const f32x4 (&acc)[2][2][4][2], const Unit& u, int wr, int wc, int fr, int fq) const {
        int row0 = u.pm * BM + wr * 64 + fr; asm volatile("" : "+v"(row0)); const int hid0 = u.pn * 128 + wc * 32 + 8 * fq;
#pragma unroll
        for (int ai = 0; ai < 2; ++ai)
#pragma unroll
            for (int m = 0; m < 4; ++m) { unsigned char* rowp = Hb + (size_t)(row0 + ai * HALF + m * 16) * ldh + hid0;
                f32x4 h0, h1;
#pragma unroll
                for (int j = 0; j < 4; ++j) { h0[j] = __builtin_amdgcn_fmed3f(silu_f(acc[ai][0][m][0][j] * ascale) * (acc[ai][0][m][1][j] * (ascale * hscale)), -448.f, 448.f); h1[j] = __builtin_amdgcn_fmed3f(silu_f(acc[ai][1][m][0][j] * ascale) * (acc[ai][1][m][1][j] * (ascale * hscale)), -448.f, 448.f); }
                int w0 = __builtin_amdgcn_cvt_pk_fp8_f32(h0[0], h0[1], 0, false); w0 = __builtin_amdgcn_cvt_pk_fp8_f32(h0[2], h0[3], w0, true);
                int w1 = __builtin_amdgcn_cvt_pk_fp8_f32(h1[0], h1[1], 0, false); w1 = __builtin_amdgcn_cvt_pk_fp8_f32(h1[2], h1[3], w1, true);
                typedef int i32x2_ __attribute__((ext_vector_type(2)));
                *(i32x2_*)rowp = (i32x2_){w0, w1}; }
    }
};

template <class Epi, class Sched, bool ALIGN_EPI = false, bool SP2 = false, bool F8 = false>
__device__ __forceinline__ void gemm_phase(PG8_LAS unsigned char* lds, const int K, const Sched& S, const Epi& E, const int wave_id) {
    const int lane_ = lane_id(); const int tid_ = wave_id * 64 + lane_;
    const int tid = tid_, wid = wave_id, lane = lane_, wr = wid >> 2, wc = wid & 3, fr = lane & 15, fq = lane >> 4;
    const int nt = K / BK;
    unsigned voffA[2], voffB[2];
#pragma unroll
    for (int i = 0; i < 2; ++i) { int R, C; stage_rc(tid * 16 + i * 8192, R, C); const int Rb = Epi::PERM ? ((R & ~31) + perm32(R & 31)) : R;
        voffA[i] = (unsigned)(R * K + C) * 2u; voffB[i] = (unsigned)(Rb * K + C) * 2u; }
    const size_t kstep = (size_t)(BK * 2);
    const size_t hstep = (size_t)HALF * K * 2;
    const unsigned ldsw = (unsigned)wid * 1024u;
    const int aoff = lds_byte(wr * 64 + fr, fq * 8), boff = lds_byte(wc * 32 + fr, fq * 8);
#define PG8_SA(b, h) (((b) * 2 + (h)) * HTB)
#define PG8_SB(b, h) ((4 + (b) * 2 + (h)) * HTB)
#define PG8_STAGE(bufoff, gbase, voff) do { _Pragma("unroll") for (int _i = 0; _i < 2; ++_i) { unsigned vo_ = (voff)[_i]; if constexpr (F8) asm volatile("" : "+v"(vo_));     \
        __builtin_amdgcn_global_load_lds((const unsigned*)((const char*)(gbase) + vo_), (PG8_LAS unsigned*)(lds + (bufoff) + ldsw + _i * 8192), 16, 0, 0); } } while (0)
#define PG8_LDA(dst, b, h) do { if constexpr (F8) { _Pragma("unroll") for (int m = 0; m < 4; ++m) dst##8[m] = __builtin_shufflevector(*(const PG8_LAS i32x4*)(lds + PG8_SA(b, h) + aoff + m * 2048), *(const PG8_LAS i32x4*)(lds + PG8_SA(b, h) + aoff + m * 2048 + 1024), 0, 1, 2, 3, 4, 5, 6, 7); } \
        else { _Pragma("unroll") for (int m = 0; m < 4; ++m) _Pragma("unroll") for (int k = 0; k < 2; ++k) dst[m][k] = *(const PG8_LAS bf16x8*)(lds + PG8_SA(b, h) + aoff + m * 2048 + k * 1024); } } while (0)
#define PG8_LDB(dst, b, h) do { if constexpr (F8) { _Pragma("unroll") for (int n = 0; n < 2; ++n) dst##8[n] = __builtin_shufflevector(*(const PG8_LAS i32x4*)(lds + PG8_SB(b, h) + boff + n * 2048), *(const PG8_LAS i32x4*)(lds + PG8_SB(b, h) + boff + n * 2048 + 1024), 0, 1, 2, 3, 4, 5, 6, 7); } \
        else { _Pragma("unroll") for (int n = 0; n < 2; ++n) _Pragma("unroll") for (int k = 0; k < 2; ++k) dst[n][k] = *(const PG8_LAS bf16x8*)(lds + PG8_SB(b, h) + boff + n * 2048 + k * 1024); } } while (0)
#define PG8_MMA(ai, bj, At, Bt) do { __builtin_amdgcn_s_setprio(1); \
        if constexpr (F8) { _Pragma("unroll") for (int m = 0; m < 4; ++m) _Pragma("unroll") for (int n = 0; n < 2; ++n) { \
            acc[ai][bj][m][n] = __builtin_amdgcn_mfma_scale_f32_16x16x128_f8f6f4(Bt##8[n], At##8[m], acc[ai][bj][m][n], 0, 0, 0, 0, 0, 0); } } \
        else { _Pragma("unroll") for (int m = 0; m < 4; ++m) _Pragma("unroll") for (int n = 0; n < 2; ++n) _Pragma("unroll") for (int k = 0; k < 2; ++k) \
            acc[ai][bj][m][n] = __builtin_amdgcn_mfma_f32_16x16x32_bf16(Bt[n][k], At[m][k], acc[ai][bj][m][n], 0, 0, 0); } \
        __builtin_amdgcn_s_setprio(0); } while (0)
#define PG8_WAIT_V(n) asm volatile("s_waitcnt vmcnt(" #n ")" ::: "memory")
#define PG8_WAIT_L(n) asm volatile("s_waitcnt lgkmcnt(" #n ")" ::: "memory")
#define PG8_BAR __builtin_amdgcn_s_barrier()
#define PG8_SCHED __builtin_amdgcn_sched_barrier(0)
    Unit cur, nxt; int ui = 0;
    if (!S.next(0, cur)) return;
    f32x4 acc[2][2][4][2];
#pragma unroll
    for (int a = 0; a < 2; ++a)
#pragma unroll
        for (int b = 0; b < 2; ++b)
#pragma unroll
            for (int m = 0; m < 4; ++m)
#pragma unroll
                for (int n = 0; n < 2; ++n) acc[a][b][m][n] = (f32x4){0.f, 0.f, 0.f, 0.f};
    bf16x8 At[4][2], B0[2][2], B1[2][2]; i32x8 At8[4], B08[2], B18[2];
    const char* cA = S.a_ptr(cur); const char* cB = S.b_ptr(cur);
    S.a_ready(cur);
    if constexpr (SP2) {
        PG8_STAGE(PG8_SB(0, 0), cB, voffB); PG8_STAGE(PG8_SB(0, 1), cB + hstep, voffB); PG8_STAGE(PG8_SA(0, 0), cA, voffA); PG8_STAGE(PG8_SA(0, 1), cA + hstep, voffA);
        if (wr == 1) PG8_BAR;
        PG8_WAIT_V(2); PG8_BAR;
        PG8_STAGE(PG8_SB(1, 0), cB + kstep, voffB); PG8_STAGE(PG8_SA(1, 0), cA + kstep, voffA); PG8_STAGE(PG8_SB(1, 1), cB + hstep + kstep, voffB);
        PG8_WAIT_V(6); PG8_BAR;
    } else {
        PG8_STAGE(PG8_SB(0, 0), cB, voffB); PG8_STAGE(PG8_SA(0, 0), cA, voffA); PG8_STAGE(PG8_SB(0, 1), cB + hstep, voffB); PG8_STAGE(PG8_SA(0, 1), cA + hstep, voffA);
        if (wr == 1) PG8_BAR;
        PG8_WAIT_V(4); PG8_BAR;
        PG8_STAGE(PG8_SB(1, 0), cB + kstep, voffB); PG8_STAGE(PG8_SA(1, 0), cA + kstep, voffA); PG8_STAGE(PG8_SB(1, 1), cB + hstep + kstep, voffB);
        PG8_WAIT_V(6); PG8_BAR;
    }
    for (;;) {
        const bool has_next = S.next(ui + 1, nxt);
        const char* nA = has_next ? S.a_ptr(nxt) : cA; const char* nB = has_next ? S.b_ptr(nxt) : cB;
#pragma unroll 1
        for (int t = 0; t < nt; t += 2) {
            const bool last = (t == nt - 2);
            const char* a1 = cA + (size_t)(t + 1) * kstep;
            const char* a2 = last ? nA : cA + (size_t)(t + 2) * kstep; const char* b2 = last ? nB : cB + (size_t)(t + 2) * kstep;
            const char* a3 = a2 + kstep; const char* b3 = b2 + kstep;
            if (last && has_next) S.a_ready(nxt);
            if constexpr (SP2) {
            PG8_LDB(B0, 0, 0); PG8_LDB(B1, 0, 1); PG8_SCHED; PG8_LDA(At, 0, 0); PG8_STAGE(PG8_SA(1, 1), a1 + hstep, voffA);
            PG8_WAIT_V(8); PG8_WAIT_L(0); PG8_BAR; PG8_MMA(0, 0, At, B0); PG8_MMA(0, 1, At, B1); PG8_BAR; PG8_SCHED;
            PG8_LDA(At, 0, 1); PG8_STAGE(PG8_SB(0, 0), b2, voffB); PG8_STAGE(PG8_SB(0, 1), b2 + hstep, voffB); PG8_STAGE(PG8_SA(0, 0), a2, voffA);
            PG8_WAIT_V(8); PG8_WAIT_L(0); PG8_BAR; PG8_MMA(1, 0, At, B0); PG8_MMA(1, 1, At, B1); PG8_BAR; PG8_SCHED;
            PG8_LDB(B0, 1, 0); PG8_LDB(B1, 1, 1); PG8_SCHED; PG8_LDA(At, 1, 0); PG8_STAGE(PG8_SA(0, 1), a2 + hstep, voffA);
            PG8_WAIT_V(8); PG8_WAIT_L(0); PG8_BAR; PG8_MMA(0, 0, At, B0); PG8_MMA(0, 1, At, B1); PG8_BAR; PG8_SCHED;
            PG8_LDA(At, 1, 1); PG8_STAGE(PG8_SB(1, 0), b3, voffB); PG8_STAGE(PG8_SB(1, 1), b3 + hstep, voffB); PG8_STAGE(PG8_SA(1, 0), a3, voffA);
            PG8_WAIT_V(8); PG8_WAIT_L(0); PG8_BAR; PG8_MMA(1, 0, At, B0); PG8_MMA(1, 1, At, B1); PG8_BAR; PG8_SCHED;
            } else {
            PG8_LDB(B0, 0, 0); PG8_SCHED; PG8_LDA(At, 0, 0); PG8_STAGE(PG8_SA(1, 1), a1 + hstep, voffA);
            PG8_WAIT_L(8); PG8_BAR; PG8_WAIT_L(0); PG8_MMA(0, 0, At, B0); PG8_BAR; PG8_SCHED;
            PG8_LDB(B1, 0, 1); PG8_STAGE(PG8_SB(0, 0), b2, voffB);
            PG8_BAR; PG8_WAIT_L(0); PG8_MMA(0, 1, At, B1); PG8_BAR;
            PG8_LDA(At, 0, 1); PG8_STAGE(PG8_SA(0, 0), a2, voffA);
            PG8_BAR; PG8_WAIT_L(0); PG8_MMA(1, 0, At, B0); PG8_BAR; PG8_SCHED;
            PG8_STAGE(PG8_SB(0, 1), b2 + hstep, voffB);
            PG8_WAIT_V(6); PG8_BAR; PG8_MMA(1, 1, At, B1); PG8_BAR;
            PG8_LDB(B0, 1, 0); PG8_SCHED; PG8_LDA(At, 1, 0); PG8_STAGE(PG8_SA(0, 1), a2 + hstep, voffA);
            PG8_WAIT_L(8); PG8_BAR; PG8_WAIT_L(0); PG8_MMA(0, 0, At, B0); PG8_BAR; PG8_SCHED;
            PG8_LDB(B1, 1, 1); PG8_STAGE(PG8_SB(1, 0), b3, voffB);
            PG8_BAR; PG8_WAIT_L(0); PG8_MMA(0, 1, At, B1); PG8_BAR;
            PG8_LDA(At, 1, 1); PG8_STAGE(PG8_SA(1, 0), a3, voffA);
            PG8_BAR; PG8_WAIT_L(0); PG8_MMA(1, 0, At, B0); PG8_BAR; PG8_SCHED;
            PG8_STAGE(PG8_SB(1, 1), b3 + hstep, voffB);
            PG8_WAIT_V(6); PG8_BAR; PG8_MMA(1, 1, At, B1); PG8_BAR;
            }
        }
        if constexpr (ALIGN_EPI) { if (wr == 0) PG8_BAR; }
        if constexpr (!Epi::AFTER_DRAIN) { E(acc, cur, wr, wc, fr, fq); S.done(cur); }
        if (!has_next) break;
#pragma unroll
        for (int a = 0; a < 2; ++a)
#pragma unroll
            for (int b = 0; b < 2; ++b)
#pragma unroll
                for (int m = 0; m < 4; ++m)
#pragma unroll
                    for (int n = 0; n < 2; ++n) acc[a][b][m][n] = (f32x4){0.f, 0.f, 0.f, 0.f};
        cur = nxt; cA = nA; cB = nB; ++ui;
        if constexpr (ALIGN_EPI) { if (wr == 1) PG8_BAR; }
    }
    PG8_WAIT_V(0);
    if constexpr (!ALIGN_EPI) { if (wr == 0) PG8_BAR; }
    PG8_BAR;
    if constexpr (Epi::AFTER_DRAIN) { E.fused(acc, cur, wr, wc, fr, fq, lds, wid, lane); S.done(cur); }
#undef PG8_SA
#undef PG8_SB
#undef PG8_STAGE
#undef PG8_LDA
#undef PG8_LDB
#undef PG8_MMA
#undef PG8_WAIT_V
#undef PG8_WAIT_L
#undef PG8_BAR
#undef PG8_SCHED
}
}

#define GAS __attribute__((address_space(1)))
#define LAS __attribute__((address_space(3)))
typedef unsigned short bf16;
typedef unsigned v4u __attribute__((ext_vector_type(4)));
typedef float f32x4 __attribute__((ext_vector_type(4)));
typedef short bf16x8 __attribute__((ext_vector_type(8)));
typedef GAS unsigned gu32;
typedef GAS unsigned long long gu64;
#define RLX_AGENT __ATOMIC_RELAXED, __HIP_MEMORY_SCOPE_AGENT
#define LDS_WAIT() asm volatile("s_waitcnt lgkmcnt(0)" ::: "memory")
#define VM_WAIT() asm volatile("s_waitcnt vmcnt(0)" ::: "memory")
__device__ __forceinline__ unsigned long long rt() { return __builtin_amdgcn_s_memrealtime(); }
__device__ __forceinline__ unsigned f2bf(float f) { unsigned u = __builtin_bit_cast(unsigned, f); return (u + 0x7fffu + ((u >> 16) & 1u)) >> 16; }
__device__ __forceinline__ unsigned pk2(float lo, float hi) { return f2bf(lo) | (f2bf(hi) << 16); }

#define XB_TMO      128
#define XB_XCNT(j)  (256  + 64 * (j))
#define XB_XSUB(j)  (1280 + 64 * (j))
#define XB_XGEN(j)  (2304 + 64 * (j))
#define XB_TOP      3328
#define XB_TOPGEN   3392
#define XCD_BAR_WORDS 3456
#define XB_SPIN_CAP (1u << 18)

__device__ __forceinline__ unsigned xb_ld(unsigned* p)              { return __hip_atomic_load(p, __ATOMIC_RELAXED, __HIP_MEMORY_SCOPE_AGENT); }
__device__ __forceinline__ unsigned xb_add(unsigned* p, unsigned v) { return __hip_atomic_fetch_add(p, v, __ATOMIC_RELAXED, __HIP_MEMORY_SCOPE_AGENT); }
__device__ __forceinline__ unsigned xb_xcc_id() { return (unsigned)__builtin_amdgcn_s_getreg((3 << 11) | 20) & 0xFu; }
#define XB_SPIN(cond, bar) do { unsigned _sp = 0; while (cond) { __builtin_amdgcn_s_sleep(1); \
    if ((++_sp & 255u) == 0u) { if (xb_ld(&(bar)[XB_TMO])) break; if (_sp > XB_SPIN_CAP) { atomicAdd(&(bar)[XB_TMO], 1u); break; } } } } while (0)

struct XcdBarrier {
    unsigned* bar; unsigned x;
    volatile LAS unsigned* st;
};

__device__ __forceinline__ XcdBarrier xcd_barrier_post(unsigned* bar, volatile LAS unsigned* st, const bool tid0) {
    XcdBarrier b; b.bar = bar; b.x = xb_xcc_id(); b.st = st;
    if (tid0) (void)xb_add(&bar[XB_XCNT(b.x)], 1u);
    return b;
}
__device__ __forceinline__ void xcd_barrier_complete(unsigned* bar, unsigned x, unsigned& nloc, unsigned& nx) {
    const unsigned G = gridDim.x * gridDim.y * gridDim.z;
    unsigned sum, cnt, mine, sp = 0u;
    for (;;) {
        sum = 0u; cnt = 0u; mine = 0u;
#pragma unroll
        for (unsigned j = 0; j < 16; ++j) { const unsigned c = xb_ld(&bar[XB_XCNT(j)]); sum += c; cnt += (c > 0u) ? 1u : 0u; mine = (j == x) ? c : mine; }
        if (sum == G) break;
        __builtin_amdgcn_s_sleep(1);
        if ((++sp & 255u) == 0u) { if (xb_ld(&bar[XB_TMO])) break; if (sp > XB_SPIN_CAP) { atomicAdd(&bar[XB_TMO], 1u); break; } }
    }
    nloc = mine > 0u ? mine : 1u; nx = cnt > 0u ? cnt : 1u;
}

__device__ __forceinline__ void xcd_barrier(const XcdBarrier& b, const int wave_id) {
    const bool tid0 = wave_id == 0 && lane_id() == 0;
    asm volatile("s_waitcnt vmcnt(0)" ::: "memory");
    __syncthreads();
    if (tid0) {
        unsigned* bar = b.bar;
        __builtin_amdgcn_s_waitcnt(0);
        unsigned nloc = b.st[0], nx = b.st[1];
        if (nloc == 0u) { xcd_barrier_complete(bar, b.x, nloc, nx); b.st[0] = nloc; b.st[1] = nx; }
        const unsigned old = xb_add(&bar[XB_XSUB(b.x)], 1u);
        const unsigned gen = old / nloc;
        if (old + 1u == (gen + 1u) * nloc) {
            __builtin_amdgcn_fence(__ATOMIC_RELEASE, "agent");
            asm volatile("s_waitcnt vmcnt(0)" ::: "memory");
            const unsigned og = xb_add(&bar[XB_TOP], 1u);
            const unsigned tg = og / nx;
            if (og + 1u == (tg + 1u) * nx) xb_add(&bar[XB_TOPGEN], 1u);
            else XB_SPIN(xb_ld(&bar[XB_TOPGEN]) == tg, bar);
            __builtin_amdgcn_fence(__ATOMIC_ACQUIRE, "agent");
            xb_add(&bar[XB_XGEN(b.x)], 1u);
            asm volatile("s_waitcnt vmcnt(0)" ::: "memory");
        } else {
            XB_SPIN(xb_ld(&bar[XB_XGEN(b.x)]) == gen, bar);
            __builtin_amdgcn_fence(__ATOMIC_ACQUIRE, "agent");
            asm volatile("s_waitcnt vmcnt(0)" ::: "memory");
        }
    }
    __syncthreads();
}


namespace att {
constexpr int D = 128, PITCH = 2048;
constexpr float SCALE = 0.08838834764831845f;
constexpr float THR = 8.f;
constexpr int NW = 8, QBLK = 32, KVBLK = 64, QB = NW * QBLK;
constexpr int SHM_V = KVBLK * D * 2, SHM_K = KVBLK * D * 2;
constexpr int LDS_BYTES = 2 * SHM_V + 2 * SHM_K + NW * 64 * 4;
constexpr float OSC = 128.f;
constexpr int WBIG = 0x40000000;
typedef unsigned short u16;
typedef short bf16x8 __attribute__((ext_vector_type(8)));
typedef short s16x4 __attribute__((ext_vector_type(4)));
typedef float f32x16 __attribute__((ext_vector_type(16)));
typedef float f32x4 __attribute__((ext_vector_type(4)));
typedef unsigned u32x4 __attribute__((ext_vector_type(4)));

#define KSWZ(row, colB) ((row) * 256 + ((colB) ^ (((row) & 7) << 4)))
#define SBAR() __builtin_amdgcn_sched_barrier(0)
__device__ __forceinline__ int v_st(int k, int c) { const int kk = (k & ~0xC) | ((k & 4) << 1) | ((k & 8) >> 1); return ((kk >> 3) * 4 + (c >> 5)) * 512 + ((kk & 7) * 32 + (c & 31)) * 2; }
__device__ __forceinline__ int v_rd_base(int lane) { return ((lane & 3) << 3) | (((lane >> 2) & 3) << 6) | (((lane >> 4) & 1) << 5) | (((lane >> 5) & 1) << 8); }
constexpr int v_rd_off(int d0, int ks, int half) { return d0 * 512 + ks * 4096 + half * 2048; }
__device__ __forceinline__ int crow(int r, int hi) { return (r & 3) + 8 * (r >> 2) + 4 * hi; }
__device__ __forceinline__ unsigned cvtpk(float lo, float hi) { unsigned r; asm volatile("v_cvt_pk_bf16_f32 %0, %1, %2" : "=v"(r) : "v"(lo), "v"(hi)); return r; }
__device__ __forceinline__ bf16x8 load8(const u16* p) { return *reinterpret_cast<const bf16x8*>(p); }
__device__ __forceinline__ void mask_tile(f32x16& p0, f32x16& p1, int dq, unsigned W) {
    const float NEG = -__builtin_inff();
#pragma unroll
    for (int r = 0; r < 16; ++r) {
        const int c = (r & 3) + 8 * (r >> 2);
        if ((unsigned)(dq - c) >= W) p0[r] = NEG;
        if ((unsigned)(dq - c - 32) >= W) p1[r] = NEG;
    }
}
__device__ __forceinline__ void partialSM(f32x16& p0, f32x16& p1, float& m_reg, float& mn, float& alpha, const bool ok) {
    float pmax = p0[0]; for (int r = 1; r < 16; ++r) pmax = fmaxf(pmax, p0[r]); for (int r = 0; r < 16; ++r) pmax = fmaxf(pmax, p1[r]);
    { auto rr = __builtin_amdgcn_permlane32_swap(__float_as_uint(pmax), __float_as_uint(pmax), false, false);
      pmax = fmaxf(__uint_as_float(rr[0]), __uint_as_float(rr[1])); }
    pmax = ok ? pmax : -__builtin_inff();
    constexpr float C2 = 1.4426950408889634f * SCALE;
    if (__builtin_expect(__all((pmax - m_reg) * SCALE <= THR), 1)) { mn = m_reg; alpha = 1.f; }
    else { mn = fmaxf(m_reg, pmax); alpha = __builtin_amdgcn_exp2f((m_reg - mn) * C2); m_reg = mn; }
    const float mnL = ok ? -mn * C2 : -__builtin_inff();
    for (int r = 0; r < 16; ++r) p0[r] = fmaf(p0[r], C2, mnL); for (int r = 0; r < 16; ++r) p1[r] = fmaf(p1[r], C2, mnL);
    for (int r = 0; r < 16; ++r) p0[r] = __builtin_amdgcn_exp2f(p0[r]);
}
__device__ __forceinline__ void finishSM(f32x16& p0, f32x16& p1, float alpha, float& l_reg, bf16x8& pa0, bf16x8& pa1, bf16x8& pa2, bf16x8& pa3) {
    for (int r = 0; r < 16; ++r) p1[r] = __builtin_amdgcn_exp2f(p1[r]);
    float ps = 0; for (int r = 0; r < 16; ++r) ps += p0[r]; for (int r = 0; r < 16; ++r) ps += p1[r];
    { auto rr = __builtin_amdgcn_permlane32_swap(__float_as_uint(ps), __float_as_uint(ps), false, false);
      ps = __uint_as_float(rr[0]) + __uint_as_float(rr[1]); }
    l_reg = l_reg * alpha + ps;
#define PK4(P, B_, OUT) do { unsigned a0 = cvtpk(P[B_+0], P[B_+1]), a1 = cvtpk(P[B_+2], P[B_+3]);                          \
        unsigned b0 = cvtpk(P[B_+4], P[B_+5]), b1 = cvtpk(P[B_+6], P[B_+7]);                                             \
        auto r0 = __builtin_amdgcn_permlane32_swap(a0, b0, false, false); auto r1 = __builtin_amdgcn_permlane32_swap(a1, b1, false, false); \
        u32x4 w = {r0[0], r1[0], r0[1], r1[1]}; OUT = *reinterpret_cast<bf16x8*>(&w); } while (0)
    PK4(p0, 0, pa0); PK4(p0, 8, pa1); PK4(p1, 0, pa2); PK4(p1, 8, pa3);
#undef PK4
}
template <int KB>
__device__ __forceinline__ void qkt(f32x16& p0, f32x16& p1, const char* K_lds, int r32, int hi, const bf16x8* qr) {
    p0 = f32x16{}; p1 = f32x16{};
    const char* kb[4];
#pragma unroll
    for (int dd = 0; dd < 4; ++dd) kb[dd] = K_lds + KB * SHM_K + KSWZ(r32, (dd * 16 + hi * 8) * 2);
#pragma unroll
    for (int d0 = 0; d0 < 8; ++d0) { const char* a = kb[d0 & 3] + (d0 >> 2) * 128;
        bf16x8 b0 = *reinterpret_cast<const bf16x8*>(a);
        bf16x8 b1 = *reinterpret_cast<const bf16x8*>(a + 32 * 256);
        p0 = __builtin_amdgcn_mfma_f32_32x32x16_bf16(b0, qr[d0], p0, 0, 0, 0);
        p1 = __builtin_amdgcn_mfma_f32_32x32x16_bf16(b1, qr[d0], p1, 0, 0, 0); }
}
template <int VB>
__device__ __forceinline__ void pv_tile(f32x16* o, int vb0, bf16x8 pa0, bf16x8 pa1, bf16x8 pa2, bf16x8 pa3) {
#define TRRD(dst, off) asm volatile("ds_read_b64_tr_b16 %0, %1 offset:%2" : "=&v"(dst) : "v"(vb0), "i"(off) : "memory")
#define PV_D0(d0) do { s16x4 l0, l1, l2, l3, h0, h1, h2, h3; constexpr int b_ = VB * SHM_V + v_rd_off(d0, 0, 0);     \
        TRRD(l0, b_); TRRD(h0, b_ + 2048); TRRD(l1, b_ + 4096); TRRD(h1, b_ + 6144); TRRD(l2, b_ + 8192); TRRD(h2, b_ + 10240); TRRD(l3, b_ + 12288); TRRD(h3, b_ + 14336); \
        asm volatile("s_waitcnt lgkmcnt(0)" ::: "memory"); SBAR();                 \
        o[d0] = __builtin_amdgcn_mfma_f32_32x32x16_bf16(pa0, (bf16x8){l0[0], l0[1], l0[2], l0[3], h0[0], h0[1], h0[2], h0[3]}, o[d0], 0, 0, 0);   \
        o[d0] = __builtin_amdgcn_mfma_f32_32x32x16_bf16(pa1, (bf16x8){l1[0], l1[1], l1[2], l1[3], h1[0], h1[1], h1[2], h1[3]}, o[d0], 0, 0, 0);   \
        o[d0] = __builtin_amdgcn_mfma_f32_32x32x16_bf16(pa2, (bf16x8){l2[0], l2[1], l2[2], l2[3], h2[0], h2[1], h2[2], h2[3]}, o[d0], 0, 0, 0);   \
        o[d0] = __builtin_amdgcn_mfma_f32_32x32x16_bf16(pa3, (bf16x8){l3[0], l3[1], l3[2], l3[3], h3[0], h3[1], h3[2], h3[3]}, o[d0], 0, 0, 0); } while (0)
    PV_D0(0); PV_D0(1); PV_D0(2); PV_D0(3);
#undef PV_D0
#undef TRRD
}
struct BlockRef { const u16* Q; const u16* K; const u16* V; unsigned char* O; const float* KM; int P0; };
struct Seam { bf16x8 qr[8]; bf16x8 st_v0, st_v1, st_k0, st_k1; };
#define ROW(p, k0, rr) ((p) + (size_t)((k0) + (rr)) * PITCH + sc)
#define VMW() asm volatile("s_waitcnt vmcnt(0)" ::: "memory")
#define VMWN(n) asm volatile("s_waitcnt vmcnt(%0)" :: "i"(n) : "memory")
#define SLOAD_H(Kp, Vp, k0) do { S.st_v0 = load8(ROW(Vp, k0, sr)); S.st_v1 = load8(ROW(Vp, k0, 32 + sr));              \
                         S.st_k0 = load8(ROW(Kp, k0, sr)); S.st_k1 = load8(ROW(Kp, k0, 32 + sr)); } while (0)
#define SWRITE_HK(bf) do { *(bf16x8*)(K_lds + (bf) * SHM_K + kws) = S.st_k0; *(bf16x8*)(K_lds + (bf) * SHM_K + kws + 32 * 256) = S.st_k1; } while (0)
#define SWRITE_HV(bf) do { *(bf16x8*)(V_lds + (bf) * SHM_V + vst0) = S.st_v0; *(bf16x8*)(V_lds + (bf) * SHM_V + vst1) = S.st_v1; } while (0)
#define SWRITE_H(bf) do { SWRITE_HV(bf); SWRITE_HK(bf); } while (0)
__device__ __forceinline__ void moba_prime(const BlockRef& cur, char* lds, Seam& S, const int wid, const int lane) {
    const int tid = wid * 64 + lane, r32 = lane & 31, hi = lane >> 5;
    const int sr = tid >> 4, sc = (tid & 15) * 8, kws = KSWZ(sr, sc * 2); char* K_lds = lds + 2 * SHM_V;
    for (int d0 = 0; d0 < 8; ++d0) S.qr[d0] = load8(cur.Q + (size_t)(wid * QBLK + r32) * PITCH + d0 * 16 + hi * 8);
    SLOAD_H(cur.K, cur.V, 0); VMW(); SWRITE_HK(0);
    __syncthreads();
}
__device__ __forceinline__ void moba_block(const BlockRef& cur, const BlockRef& nxt, char* lds, Seam& S, const int wid, const int lane) {
    const int tid = wid * 64 + lane, r32 = lane & 31, hi = lane >> 5;
    const int qbi = cur.P0 >> 8;
    const int NT = 4 * (qbi + 1);
    const int W = WBIG;
    const int qlo = cur.P0 + wid * QBLK, qm = qlo + r32 - 4 * hi;
    char* V_lds = lds; char* K_lds = lds + 2 * SHM_V;
    float* ws = (float*)(lds + 2 * SHM_V + 2 * SHM_K) + wid * 64; float* li_l = ws, * al_l = ws + 32;
    float m_reg = -1e30f, l_reg = 0; f32x16 o[4] = {};
    const int sr = tid >> 4, sc = (tid & 15) * 8, vst0 = v_st(sr, sc), vst1 = v_st(32 + sr, sc), kws = KSWZ(sr, sc * 2);
    const int vb0 = (int)(uintptr_t)V_lds + v_rd_base(lane);
    const u16* Kh = cur.K; const u16* Vh = cur.V;
    unsigned sel = 0u;
    if (qbi > 0) {
        f32x16 pg = f32x16{};
        bf16x8 kf[8];
#pragma unroll
        for (int d0 = 0; d0 < 8; ++d0) { const f32x4 a = *(const f32x4*)(cur.KM + (r32 & 15) * D + d0 * 16 + hi * 8), b4 = *(const f32x4*)(cur.KM + (r32 & 15) * D + d0 * 16 + hi * 8 + 4);
            u32x4 w = {cvtpk(a[0], a[1]), cvtpk(a[2], a[3]), cvtpk(b4[0], b4[1]), cvtpk(b4[2], b4[3])}; kf[d0] = *reinterpret_cast<bf16x8*>(&w); }
#pragma unroll
        for (int d0 = 0; d0 < 8; ++d0) pg = __builtin_amdgcn_mfma_f32_32x32x16_bf16(kf[d0], S.qr[d0], pg, 0, 0, 0);
        float g[16];
#pragma unroll
        for (int r = 0; r < 8; ++r) { const float own = pg[r], oth = __shfl_xor(own, 32);
            const int j0 = (r & 3) + 8 * (r >> 2);
            g[j0] = hi ? oth : own; g[j0 + 4] = hi ? own : oth; }
#pragma unroll
        for (int rep = 0; rep < 3; ++rep) { float best = -__builtin_inff(); int bi = -1;
#pragma unroll
            for (int j = 0; j < 16; ++j) if (j < qbi && !((sel >> j) & 1u) && g[j] > best) { best = g[j]; bi = j; }
            if (bi >= 0) sel |= 1u << bi; }
    }
    sel |= 0xffff0000u << 0;
#define RESC(a) do { if (__any((a) < 1.f)) { if (hi == 0) al_l[r32] = (a); asm volatile("s_waitcnt lgkmcnt(0)" ::: "memory");              \
                     for (int d_ = 0; d_ < 4; ++d_) for (int r = 0; r < 16; ++r) o[d_][r] *= al_l[crow(r, hi)]; } } while (0)
#define KBASE(t) ((t) * KVBLK)
#define ROWOK(t) ((((t) >> 2) >= qbi) || ((sel >> ((t) >> 2)) & 1u))
#define MASKT(P0_, P1_, t) do { const int kb_ = KBASE(t); if (kb_ + KVBLK - 1 > qlo) mask_tile(P0_, P1_, qm - kb_, (unsigned)W); } while (0)
    constexpr int NQL = 8;
#define SEAM_K0() do { VMWN(NQL); SWRITE_HK(0); SBAR(); } while (0)
    f32x16 pA0, pA1, pB0, pB1; float mnA, mnB, alA, alB; bf16x8 pa0, pa1, pa2, pa3;
    SWRITE_HV(0); SBAR();
    if (NT > 1) { SLOAD_H(Kh, Vh, KBASE(1)); }
    SBAR(); qkt<0>(pA0, pA1, K_lds, r32, hi, S.qr);
    MASKT(pA0, pA1, 0); partialSM(pA0, pA1, m_reg, mnA, alA, ROWOK(0));
    if (NT > 1) { VMW(); SWRITE_H(1); }
    __syncthreads();
#define HALF_STEP(PX0, PX1, mnX, alX, PY0, PY1, alY, t, KB, VB, SB) do {                                                      \
        SBAR(); qkt<KB>(PX0, PX1, K_lds, r32, hi, S.qr);                                                                      \
        finishSM(PY0, PY1, alY, l_reg, pa0, pa1, pa2, pa3); SBAR();                                                           \
        if ((t) + 1 < NT) { SLOAD_H(Kh, Vh, KBASE((t) + 1)); SBAR(); }                                                        \
        pv_tile<VB>(o, vb0, pa0, pa1, pa2, pa3); MASKT(PX0, PX1, (t)); partialSM(PX0, PX1, m_reg, mnX, alX, ROWOK(t));       \
        __syncthreads();                                                                                                      \
        if ((t) + 1 < NT) { VMW(); SWRITE_H(SB); }                                                                            \
        RESC(alX); __syncthreads(); } while (0)
    for (int t = 1; t + 1 < NT; t += 2) {
        HALF_STEP(pB0, pB1, mnB, alB, pA0, pA1, alA, t, 1, 0, 0);
        HALF_STEP(pA0, pA1, mnA, alA, pB0, pB1, alB, t + 1, 0, 1, 1);
    }
    SBAR(); qkt<1>(pB0, pB1, K_lds, r32, hi, S.qr); SBAR();
    SLOAD_H(nxt.K, nxt.V, 0); SBAR();
#pragma unroll
    for (int d0 = 0; d0 < 8; ++d0) S.qr[d0] = load8(nxt.Q + (size_t)(wid * QBLK + r32) * PITCH + d0 * 16 + hi * 8);
    SBAR();
    finishSM(pA0, pA1, alA, l_reg, pa0, pa1, pa2, pa3); SBAR();
    pv_tile<0>(o, vb0, pa0, pa1, pa2, pa3);
    MASKT(pB0, pB1, NT - 1); partialSM(pB0, pB1, m_reg, mnB, alB, ROWOK(NT - 1)); __syncthreads(); RESC(alB);
    finishSM(pB0, pB1, alB, l_reg, pa0, pa1, pa2, pa3); SBAR(); pv_tile<1>(o, vb0, pa0, pa1, pa2, pa3);
    SBAR(); SEAM_K0();
    if (hi == 0) li_l[r32] = l_reg; asm volatile("s_waitcnt lgkmcnt(0)" ::: "memory");
    float rli[16];
#pragma unroll
    for (int r = 0; r < 16; ++r) rli[r] = __builtin_amdgcn_rcpf(li_l[crow(r, hi)]);
    int le_ = lane; asm volatile("" : "+v"(le_));
    unsigned char* Ow = cur.O + (unsigned)((wid * QBLK + 4 * (le_ >> 5)) * PITCH + (le_ & 31));
#pragma unroll
    for (int r = 0; r < 16; ++r) { const int orow0 = (r & 3) + 8 * (r >> 2);
#pragma unroll
        for (int d0 = 0; d0 < 4; ++d0) { const float v = __builtin_amdgcn_fmed3f(o[d0][r] * rli[r] * OSC, -448.f, 448.f);
            const float vn = __shfl_xor(v, 1);
            const int p2 = __builtin_amdgcn_cvt_pk_fp8_f32(v, vn, 0, false);
            const int p4 = __shfl_xor(p2, 2);
            if ((r32 & 3) == 0) *(unsigned*)(Ow + (size_t)orow0 * PITCH + d0 * 32) = ((unsigned)p2 & 0xffffu) | ((unsigned)p4 << 16); } }
    __syncthreads();
#undef RESC
#undef KBASE
#undef ROWOK
#undef MASKT
#undef SEAM_K0
#undef HALF_STEP
}
#undef ROW
#undef VMW
#undef VMWN
#undef SLOAD_H
#undef SWRITE_HK
#undef SWRITE_HV
#undef SWRITE_H
#undef KSWZ
#undef SBAR
}

constexpr int NWAVES = 8, NTHR = 512;
constexpr int BATCH = 4, SEQ = 4096, T = BATCH * SEQ, D = 2048, NH = 16, HD = 128, DEPTH = 4;
constexpr int NQKV = 3 * D, NHIN = 4 * D, NEXP = 32, DEXP = 512, MBLK = 256, NBLK = SEQ / MBLK;
constexpr float ALPHA = 1.6817928305074290f;
constexpr float LN_EPS = 1e-5f, RMS_EPS = 1e-6f;
constexpr float QSCALE = 0.08838834764831845f;
constexpr float W8_SCALE = 128.f, H8_SCALE = 16.f, O8_SCALE = 128.f, Y8_SCALE = 256.f;
constexpr int MAXTILES = 160;

constexpr size_t MiB = 1u << 20;
constexpr size_t WS_CTL = 0, CTL_ZERO_BYTES = 2 * MiB;
constexpr size_t WS_KS = 1 * MiB;
constexpr size_t WS_WQKV = 2 * MiB;
constexpr size_t WS_WOM = 50 * MiB;
constexpr size_t WS_WHIN = 66 * MiB;
constexpr size_t WS_WOH = 130 * MiB;
constexpr size_t WS_W1 = 146 * MiB;
constexpr size_t WS_W2 = 658 * MiB;
constexpr size_t WS_X = 914 * MiB;
constexpr size_t WS_XB = 1042 * MiB;
constexpr size_t WS_Y = 1106 * MiB;
constexpr size_t WS_OB = 1234 * MiB;
constexpr size_t WS_R1 = 1298 * MiB;
constexpr size_t WS_H = 1618 * MiB;
constexpr size_t WS_KM = 1658 * MiB;
constexpr size_t WS_TI = 1659 * MiB;
constexpr size_t WS_WR = 1660 * MiB;
constexpr size_t WS_XL = 1662 * MiB;
constexpr size_t WS_XB8 = 1726 * MiB;
constexpr size_t WS_END = 1758 * MiB;
constexpr int CW_TMO = 0, CW_CODE = 1, CW_BAR = 4096, CW_CNT = 16384;

constexpr int RING_OFF = 0, RING_BYTES = 131072;
constexpr int LDSCTL_OFF = RING_BYTES, MISC_OFF = LDSCTL_OFF + 320;
constexpr int TAB_OFF = LDSCTL_OFF + 1024;
constexpr int LDS_BYTES = 147456;

struct Frame {
    LAS unsigned char* lds;
    volatile LAS unsigned* MISC;
    gu32* ctl;
    int vcu, G, wave;
    unsigned char* ws;
};

__device__ __forceinline__ float wave_sum(float v) {
#pragma unroll
    for (int o = 1; o < 64; o <<= 1) v += __shfl_xor(v, o);
    return v;
}
__device__ __forceinline__ unsigned pk4_fp8(float a, float b, float c, float d) { int w = __builtin_amdgcn_cvt_pk_fp8_f32(a, b, 0, false); w = __builtin_amdgcn_cvt_pk_fp8_f32(c, d, w, true); return (unsigned)w; }
__device__ __forceinline__ float bf2f(unsigned short b) { return __builtin_bit_cast(float, (unsigned)b << 16); }
__device__ __forceinline__ float bflo(unsigned w) { return __builtin_bit_cast(float, w << 16); }
__device__ __forceinline__ float bfhi(unsigned w) { return __builtin_bit_cast(float, w & 0xffff0000u); }

constexpr int CV_NDEF = 2048;
constexpr int CV_NTILES_ALL = 2 * ((D / 128) * (NQKV / 128)) + 4 * ((D / 128) * (D / 128)) + 2 * ((D / 128) * (NHIN / 128)) + 3 * 128 * ((D / 128) * (DEXP / 128));
__device__ __forceinline__ int cv_skip(int j, int d1, int d2, int d3) { int t = j; if (t >= d1) t += CV_NDEF; if (t >= d2) t += CV_NDEF; if (t >= d3) t += CV_NDEF; return t; }
template <int MODE>
__device__ __forceinline__ void conv_tiles(Frame& F, const float* const* in, const int j0, const int jstride, const int jend, const int lay, const int tid) {
    {
        LAS float* Ls = (LAS float*)(F.lds + RING_OFF);
        constexpr int TS = 129;
        constexpr int T_A = (D / 128) * (NQKV / 128), T_B = (D / 128) * (D / 128), T_C = (D / 128) * (NHIN / 128), T_E = (D / 128) * (DEXP / 128);
        constexpr int NTILES = 2 * T_A + 2 * T_B + 2 * T_C + 2 * T_B + 3 * 128 * T_E;
        constexpr int DOWN0 = NTILES - 128 * T_E;
#define CV_TILE(j_) (MODE == 1 ? (DOWN0 + lay * 32 * T_E + (j_)) : cv_skip((j_), DOWN0 + 1 * 32 * T_E, DOWN0 + 2 * 32 * T_E, DOWN0 + 3 * 32 * T_E))
        unsigned char* Wqkv = F.ws + WS_WQKV; unsigned char* Wom = F.ws + WS_WOM; bf16* Whin = (bf16*)(F.ws + WS_WHIN); bf16* Woh = (bf16*)(F.ws + WS_WOH);
        unsigned char* W1 = F.ws + WS_W1; unsigned char* W2 = F.ws + WS_W2;
#define P0_DECODE(it_, Wsrc, K_, N_, dst, kind, par, k0_, n0_) do { int r_ = (it_); \
        if (r_ < 2 * T_A) { const int m_ = r_ / T_A; r_ -= m_ * T_A; Wsrc = in[1] + (size_t)m_ * D * NQKV; K_ = D; N_ = NQKV; dst = Wqkv + (size_t)m_ * NQKV * D; kind = 1; par = 0; } \
        else if ((r_ -= 2 * T_A) < 2 * T_B) { const int m_ = r_ / T_B; r_ -= m_ * T_B; Wsrc = in[2] + (size_t)m_ * D * D; K_ = D; N_ = D; dst = Wom + (size_t)m_ * D * D; kind = 1; par = 0; } \
        else if ((r_ -= 2 * T_B) < 2 * T_C) { const int m_ = r_ / T_C; r_ -= m_ * T_C; Wsrc = in[3] + (size_t)m_ * D * NHIN; K_ = D; N_ = NHIN; dst = (unsigned char*)(Whin + (size_t)m_ * NHIN * D); kind = 0; par = 0; } \
        else if ((r_ -= 2 * T_C) < 2 * T_B) { const int m_ = r_ / T_B; r_ -= m_ * T_B; Wsrc = in[6] + (size_t)m_ * D * D; K_ = D; N_ = D; dst = (unsigned char*)(Woh + (size_t)m_ * D * D); kind = 0; par = 0; } \
        else if ((r_ -= 2 * T_B) < 128 * T_E) { const int m_ = r_ / T_E; r_ -= m_ * T_E; Wsrc = in[13] + (size_t)m_ * D * DEXP; K_ = D; N_ = DEXP; dst = W1 + (size_t)m_ * 1024 * D; kind = 2; par = 0; } \
        else if ((r_ -= 128 * T_E) < 128 * T_E) { const int m_ = r_ / T_E; r_ -= m_ * T_E; Wsrc = in[14] + (size_t)m_ * D * DEXP; K_ = D; N_ = DEXP; dst = W1 + (size_t)m_ * 1024 * D; kind = 2; par = 1; } \
        else { r_ -= 128 * T_E; const int m_ = r_ / T_E; r_ -= m_ * T_E; Wsrc = in[15] + (size_t)m_ * DEXP * D; K_ = DEXP; N_ = D; dst = W2 + (size_t)m_ * D * DEXP; kind = 1; par = 0; } \
        { const int nb_ = N_ / 128; k0_ = 128 * (r_ / nb_); n0_ = 128 * (r_ % nb_); } } while (0)
        f32x4 v[8];
        int it = j0;
        if (it < jend) { const float* Wsrc; int K_, N_, kind, par, k0_, n0_; unsigned char* dst; P0_DECODE(CV_TILE(it), Wsrc, K_, N_, dst, kind, par, k0_, n0_); (void)dst; (void)kind; (void)par;
#pragma unroll
            for (int i = 0; i < 8; ++i) { const int idx = tid + 512 * i, kr = idx >> 5, n4 = (idx & 31) * 4; v[i] = *(const GAS f32x4*)(Wsrc + (size_t)(k0_ + kr) * N_ + n0_ + n4); } }
#pragma unroll 1
        for (; it < jend; it += jstride) {
            const float* Wsrc; int K_, N_, kind, par, k0_, n0_; unsigned char* dst; P0_DECODE(CV_TILE(it), Wsrc, K_, N_, dst, kind, par, k0_, n0_); (void)Wsrc;
#pragma unroll
            for (int i = 0; i < 8; ++i) { const int idx = tid + 512 * i, kr = idx >> 5, n4 = (idx & 31) * 4; LAS float* p = Ls + kr * TS + n4; p[0] = v[i].x; p[1] = v[i].y; p[2] = v[i].z; p[3] = v[i].w; }
            LDS_WAIT(); __builtin_amdgcn_s_barrier(); asm volatile("" ::: "memory");
            if (it + jstride < jend) { const float* Wn; int Kn, Nn, kindn, parn, k0n, n0n; unsigned char* dstn; P0_DECODE(CV_TILE(it + jstride), Wn, Kn, Nn, dstn, kindn, parn, k0n, n0n); (void)dstn; (void)kindn; (void)parn; (void)Kn;
#pragma unroll
                for (int i = 0; i < 8; ++i) { const int idx = tid + 512 * i, kr = idx >> 5, n4 = (idx & 31) * 4; v[i] = *(const GAS f32x4*)(Wn + (size_t)(k0n + kr) * Nn + n0n + n4); } }
#pragma unroll
            for (int r = 0; r < 4; ++r) { const int q = tid + 512 * r, c = q & 15, nl = q >> 4;
                const LAS float* sp = Ls + (8 * c) * TS + nl;
                const float f0 = sp[0 * TS], f1 = sp[1 * TS], f2 = sp[2 * TS], f3 = sp[3 * TS], f4 = sp[4 * TS], f5 = sp[5 * TS], f6 = sp[6 * TS], f7 = sp[7 * TS];
                const int sn = n0_ + nl;
                const int drow = kind == 2 ? (256 * (sn >> 7) + 128 * ((sn >> 2) & 1) + 32 * ((sn >> 5) & 3) + 8 * ((sn >> 3) & 3) + 4 * par + (sn & 3)) : sn;
                if (kind == 0) { v4u o; o.x = pk2(f0, f1); o.y = pk2(f2, f3); o.z = pk2(f4, f5); o.w = pk2(f6, f7); *(GAS v4u*)((bf16*)dst + (size_t)drow * K_ + k0_ + 8 * c) = o; }
                else { typedef unsigned u32x2_ __attribute__((ext_vector_type(2)));
                    *(GAS u32x2_*)(dst + (size_t)drow * K_ + k0_ + 8 * c) = (u32x2_){pk4_fp8(f0 * W8_SCALE, f1 * W8_SCALE, f2 * W8_SCALE, f3 * W8_SCALE), pk4_fp8(f4 * W8_SCALE, f5 * W8_SCALE, f6 * W8_SCALE, f7 * W8_SCALE)}; } }
            LDS_WAIT(); __builtin_amdgcn_s_barrier(); asm volatile("" ::: "memory");
        }
#undef P0_DECODE
#undef CV_TILE
    }
}
__device__ __forceinline__ void p0_prologue(Frame& F, const float* const* in) {
    const int wave = F.wave; int lane = lane_id(); asm volatile("" : "+v"(lane)); const int tid = wave * 64 + lane; (void)tid;

    const int gw = F.vcu * NWAVES + wave, NGW = F.G * NWAVES;
    conv_tiles<0>(F, in, F.vcu, F.G, CV_NTILES_ALL - 3 * CV_NDEF, 0, tid);
    { bf16* WR = (bf16*)(F.ws + WS_WR);
      for (int idx = F.vcu * NTHR + tid; idx < DEPTH * 48 * D; idx += F.G * NTHR) { const int l = idx / (48 * D), n = (idx / D) % 48, k = idx % D;
          float w = 0.f; if (n < 4) w = in[9][((size_t)l * D + k) * 4 + n]; else if (n < 36) { const int g = (n - 4) >> 3, e = (n - 4) & 7; w = in[11][(((size_t)l * 4 + g) * D + k) * 8 + e]; }
          const unsigned hi = f2bf(w), lo = f2bf(w - bf2f((unsigned short)hi));
          WR[((size_t)l * 2 + 0) * 48 * D + (size_t)n * D + k] = (bf16)hi; WR[((size_t)l * 2 + 1) * 48 * D + (size_t)n * D + k] = (bf16)lo; } }
    const float* x = in[0]; unsigned char* XB8 = F.ws + WS_XB8;
#pragma unroll 1
    for (int m = gw; m < T; m += NGW) {
        const GAS f32x4* xr = (const GAS f32x4*)(x + (size_t)m * D) + lane; GAS unsigned* o4 = (GAS unsigned*)(XB8 + (size_t)m * D) + lane;
#pragma unroll
        for (int j = 0; j < 8; ++j) { const f32x4 v = xr[64 * j]; o4[64 * j] = pk4_fp8(v.x, v.y, v.z, v.w); }
    }
}


__device__ __forceinline__ att::BlockRef attn_ref(Frame& F, int L, int pass, int jj) {
    const int bh = L >> 3, x = L & 7, qb = pass ? (NBLK - 1 - x) : x, b = bh >> 4, h = bh & 15;
    const bf16* QBp = (const bf16*)(F.ws + WS_R1); unsigned char* OBp = F.ws + WS_OB; const float* KMS = (const float*)(F.ws + WS_KS) + (size_t)jj * (BATCH * NH * NBLK * HD);
    att::BlockRef r; const size_t qoff = (size_t)(b * SEQ + qb * MBLK) * D + h * HD, koff = (size_t)(b * SEQ) * D + h * HD;
    r.Q = QBp + qoff; r.K = QBp + (size_t)T * D + koff; r.V = QBp + 2 * (size_t)T * D + koff; r.O = OBp + qoff; r.KM = KMS + (size_t)bh * NBLK * HD; r.P0 = qb * MBLK;
    return r;
}
__device__ __forceinline__ void attn_mfma_phase(Frame& F, int jj) {
    const int wave = F.wave; const int lane = lane_id();
    char* ldsg = (char*)(F.lds + RING_OFF);
    constexpr int NITEM = BATCH * NH * (NBLK / 2);
    int L = F.vcu;
    if (L < NITEM) {
        int pass = 0;
        att::BlockRef cur = attn_ref(F, L, 0, jj);
        att::Seam S;
        att::moba_prime(cur, ldsg, S, wave, lane);
        for (;;) {
            const bool more_pass = pass == 0, more_item = L + F.G < NITEM, last = !more_pass && !more_item;
            int passn = pass + 1, Ln = L;
            if (!more_pass) { passn = 0; Ln = more_item ? L + F.G : L; }
            const att::BlockRef nxt = last ? cur : attn_ref(F, Ln, passn, jj);
            att::moba_block(cur, nxt, ldsg, S, wave, lane);
            if (last) break;
            cur = nxt; pass = passn; L = Ln;
        }
    }
    asm volatile("s_waitcnt vmcnt(0)" ::: "memory");
    __syncthreads();
}


namespace scn {
constexpr int RS_K = 272, RS_S = 144;
constexpr int OFF_QG = 0, OFF_QA = 17408, OFF_KA = 34816, OFF_ST = 52224, OFF_KDT = 60928, OFF_IT = 79360, OFF_AL = 83968, OFF_D = 93184, OFF_SEG = 93696, END = 97792;
typedef short bf16x8 __attribute__((ext_vector_type(8)));
typedef float f32x16 __attribute__((ext_vector_type(16)));
typedef float f32x4 __attribute__((ext_vector_type(4)));
typedef float f32x2 __attribute__((ext_vector_type(2)));
typedef unsigned u32x2 __attribute__((ext_vector_type(2)));
typedef unsigned u32x4 __attribute__((ext_vector_type(4)));
__device__ __forceinline__ unsigned pk(float lo, float hi) { unsigned r; asm volatile("v_cvt_pk_bf16_f32 %0, %1, %2" : "=v"(r) : "v"(lo), "v"(hi)); return r; }
}
__device__ __forceinline__ void scan_mfma_phase(Frame& F) {
    using namespace scn;
#define SCAN_BAR() do { asm volatile("s_waitcnt lgkmcnt(0)" ::: "memory"); __builtin_amdgcn_s_barrier(); asm volatile("" ::: "memory"); } while (0)
    const int wave = F.wave; const int lane = lane_id(); const int tid = wave * 64 + lane;
    const bf16* QH = (const bf16*)(F.ws + WS_R1); const float* LF = (const float*)(F.ws + WS_R1 + 64 * MiB); const bf16* IH = (const bf16*)(F.ws + WS_R1 + 192 * MiB); const bf16* KKH = (const bf16*)(F.ws + WS_OB);
    bf16* OSB = (bf16*)(F.ws + WS_Y);
    LAS unsigned char* L = F.lds + RING_OFF;
    const int l32 = lane & 31, kh = lane >> 5;
    const int k0 = 2 * lane;
    const int is_ = tid >> 3, iv4 = (tid & 7) * 4;
    for (int u = F.vcu; u < BATCH * NH * 4; u += F.G) {
        const int bh = u >> 2, vs = u & 3, b = bh >> 4, h = bh & 15;
        __syncthreads();
        for (int i = tid; i < 8704 / 4; i += NTHR) ((LAS unsigned*)(L + OFF_ST))[i] = 0u;
        f32x16 S = f32x16{};
        const size_t colq = (size_t)h * HD + k0, coli = (size_t)h * HD + vs * 32 + iv4;
        f32x2 lfv[2][8]; unsigned qv[2][8], kv[2][8]; u32x2 ivv[2];
#define SCAN_LOADS(p_, rb_) do { _Pragma("unroll") for (int j = 0; j < 8; ++j) { const size_t g_ = ((rb_) + 8 * wave + j) * D + colq; \
            asm volatile("global_load_dwordx2 %0, %1, off" : "=v"(lfv[p_][j]) : "v"(LF + g_)); asm volatile("global_load_dword %0, %1, off" : "=v"(qv[p_][j]) : "v"(QH + g_)); asm volatile("global_load_dword %0, %1, off" : "=v"(kv[p_][j]) : "v"(KKH + g_)); } \
          asm volatile("global_load_dwordx2 %0, %1, off" : "=v"(ivv[p_]) : "v"(IH + ((rb_) + is_) * D + coli)); } while (0)
        SCAN_LOADS(0, (size_t)(b * SEQ)); SCAN_LOADS(1, (size_t)(b * SEQ + 64));
#pragma unroll 1
        for (int c2 = 0; c2 < SEQ / 64; c2 += 2) {
#pragma unroll
          for (int p = 0; p < 2; ++p) { const int c = c2 + p;
            const size_t row0 = (size_t)(b * SEQ + c * 64);
            if (c < SEQ / 64 - 1) asm volatile("s_waitcnt vmcnt(25)" ::: "memory"); else asm volatile("s_waitcnt vmcnt(0)" ::: "memory");
#pragma unroll
            for (int j = 0; j < 8; ++j) asm volatile("" : "+v"(lfv[p][j]), "+v"(qv[p][j]), "+v"(kv[p][j]));
            asm volatile("" : "+v"(ivv[p]));
            float c0[8], c1[8];
            { float a0 = 0.f, a1 = 0.f;
#pragma unroll
              for (int j = 0; j < 8; ++j) { a0 += lfv[p][j].x; a1 += lfv[p][j].y; c0[j] = a0; c1[j] = a1; }
              *(LAS f32x2*)(L + OFF_SEG + (wave * 128 + k0) * 4) = (f32x2){a0, a1}; }
            SCAN_BAR();
            float off0 = 0.f, off1 = 0.f, gm0 = 0.f, gm1 = 0.f, gl0 = 0.f, gl1 = 0.f;
#pragma unroll
            for (int t8 = 0; t8 < 8; ++t8) { const f32x2 sv = *(const LAS f32x2*)(L + OFF_SEG + (t8 * 128 + k0) * 4);
                if (t8 < wave) { off0 += sv.x; off1 += sv.y; } if (t8 < 4) { gm0 += sv.x; gm1 += sv.y; } gl0 += sv.x; gl1 += sv.y; }
            { float kd0[8], kd1[8];
              const float egm0 = __builtin_amdgcn_exp2f(gm0), egm1 = __builtin_amdgcn_exp2f(gm1), eglm0 = __builtin_amdgcn_exp2f(gl0 - gm0), eglm1 = __builtin_amdgcn_exp2f(gl1 - gm1);
#pragma unroll
              for (int j = 0; j < 8; ++j) { const int t = 8 * wave + j;
                  const float A0 = __builtin_amdgcn_exp2f(fminf(off0 + c0[j] - gm0, 120.f)), A1 = __builtin_amdgcn_exp2f(fminf(off1 + c1[j] - gm1, 120.f));
                  const float r0 = __builtin_amdgcn_rcpf(A0), r1 = __builtin_amdgcn_rcpf(A1);
                  const float q0 = bflo(qv[p][j]) * A0, q1 = bfhi(qv[p][j]) * A1;
                  const float kk0 = bflo(kv[p][j]) * r0, kk1 = bfhi(kv[p][j]) * r1;
                  *(LAS unsigned*)(L + OFF_QG + t * RS_K + k0 * 2) = pk(q0 * egm0, q1 * egm1);
                  *(LAS unsigned*)(L + OFF_QA + t * RS_K + k0 * 2) = pk(q0, q1);
                  *(LAS unsigned*)(L + OFF_KA + t * RS_K + k0 * 2) = pk(kk0, kk1);
                  kd0[j] = kk0 * eglm0; kd1[j] = kk1 * eglm1; }
              u32x4 w0, w1; w0.x = pk(kd0[0], kd0[1]); w0.y = pk(kd0[2], kd0[3]); w0.z = pk(kd0[4], kd0[5]); w0.w = pk(kd0[6], kd0[7]);
              w1.x = pk(kd1[0], kd1[1]); w1.y = pk(kd1[2], kd1[3]); w1.z = pk(kd1[4], kd1[5]); w1.w = pk(kd1[6], kd1[7]);
              *(LAS u32x4*)(L + OFF_KDT + k0 * RS_S + wave * 16) = w0; *(LAS u32x4*)(L + OFF_KDT + (k0 + 1) * RS_S + wave * 16) = w1;
              if (wave == 0) *(LAS f32x2*)(L + OFF_D + k0 * 4) = (f32x2){__builtin_amdgcn_exp2f(gl0), __builtin_amdgcn_exp2f(gl1)}; }
            { const unsigned i0 = ivv[p].x, i1 = ivv[p].y;
              *(LAS unsigned short*)(L + OFF_IT + (iv4 + 0) * RS_S + is_ * 2) = (unsigned short)(i0 & 0xffffu); *(LAS unsigned short*)(L + OFF_IT + (iv4 + 1) * RS_S + is_ * 2) = (unsigned short)(i0 >> 16);
              *(LAS unsigned short*)(L + OFF_IT + (iv4 + 2) * RS_S + is_ * 2) = (unsigned short)(i1 & 0xffffu); *(LAS unsigned short*)(L + OFF_IT + (iv4 + 3) * RS_S + is_ * 2) = (unsigned short)(i1 >> 16); }
            SCAN_BAR();
            if (c + 2 < SEQ / 64) SCAN_LOADS(p, row0 + 128);
            f32x16 acc = f32x16{};
            int tt = 0;
            if (wave < 4) {
                f32x16 ds = f32x16{};
#pragma unroll
                for (int ss = 0; ss < 4; ++ss) { const bf16x8 a = *(const LAS bf16x8*)(L + OFF_KDT + (32 * wave + l32) * RS_S + (16 * ss + 8 * kh) * 2), bq = *(const LAS bf16x8*)(L + OFF_IT + l32 * RS_S + (16 * ss + 8 * kh) * 2);
                    ds = __builtin_amdgcn_mfma_f32_32x32x16_bf16(a, bq, ds, 0, 0, 0); }
#pragma unroll
                for (int q = 0; q < 4; ++q) { const f32x4 dd = *(const LAS f32x4*)(L + OFF_D + (32 * wave + 8 * q + 4 * kh) * 4);
#pragma unroll
                    for (int i = 0; i < 4; ++i) S[4 * q + i] = dd[i] * S[4 * q + i] + ds[4 * q + i]; }
                if (wave < 3) {
                    const int st = wave == 2 ? 1 : 0; tt = wave >= 1 ? 1 : 0;
#pragma unroll
                    for (int ks = 0; ks < 8; ++ks) { const bf16x8 a = *(const LAS bf16x8*)(L + OFF_KA + (32 * st + l32) * RS_K + (16 * ks + 8 * kh) * 2), bq = *(const LAS bf16x8*)(L + OFF_QA + (32 * tt + l32) * RS_K + (16 * ks + 8 * kh) * 2);
                        acc = __builtin_amdgcn_mfma_f32_32x32x16_bf16(a, bq, acc, 0, 0, 0); }
#pragma unroll
                    for (int q = 0; q < 4; ++q) { float v4[4];
#pragma unroll
                        for (int i = 0; i < 4; ++i) { const int sl = 8 * q + 4 * kh + i; v4[i] = (st != tt || sl <= l32) ? acc[4 * q + i] : 0.f; }
                        *(LAS u32x2*)(L + OFF_AL + (32 * tt + l32) * RS_S + (32 * st + 8 * q + 4 * kh) * 2) = (u32x2){pk(v4[0], v4[1]), pk(v4[2], v4[3])}; }
                }
            } else if (wave < 6) {
                tt = wave - 4;
#pragma unroll
                for (int ks = 0; ks < 8; ++ks) { const bf16x8 a = *(const LAS bf16x8*)(L + OFF_QG + (32 * tt + l32) * RS_K + (16 * ks + 8 * kh) * 2), bq = *(const LAS bf16x8*)(L + OFF_ST + l32 * RS_K + (16 * ks + 8 * kh) * 2);
                    acc = __builtin_amdgcn_mfma_f32_32x32x16_bf16(a, bq, acc, 0, 0, 0); }
            }
            SCAN_BAR();
            if (wave < 4) {
#pragma unroll
                for (int q = 0; q < 4; ++q) *(LAS u32x2*)(L + OFF_ST + l32 * RS_K + (32 * wave + 8 * q + 4 * kh) * 2) = (u32x2){pk(S[4 * q + 0], S[4 * q + 1]), pk(S[4 * q + 2], S[4 * q + 3])};
            } else if (wave < 6) {
#pragma unroll
                for (int ss = 0; ss < 4; ++ss) if (ss < 2 || tt == 1) { const bf16x8 a = *(const LAS bf16x8*)(L + OFF_AL + (32 * tt + l32) * RS_S + (16 * ss + 8 * kh) * 2), bq = *(const LAS bf16x8*)(L + OFF_IT + l32 * RS_S + (16 * ss + 8 * kh) * 2);
                    acc = __builtin_amdgcn_mfma_f32_32x32x16_bf16(a, bq, acc, 0, 0, 0); }
                bf16* op = OSB + (row0 + 32 * tt + 4 * kh) * D + (size_t)h * HD + vs * 32 + l32;
#pragma unroll
                for (int r = 0; r < 16; ++r) { const float nb = __shfl_xor(acc[r], 1); if ((l32 & 1) == 0) *(unsigned*)(op + (size_t)((r & 3) + 8 * (r >> 2)) * D) = pk(acc[r], nb); }
            }
            SCAN_BAR();
          }
        }
#undef SCAN_LOADS
    }
    __syncthreads();
}

#undef SCAN_BAR
__device__ __forceinline__ void gatenorm_phase(Frame& F, const float* gnorm) {
    const int wave = F.wave; int lane = lane_id(); asm volatile("" : "+v"(lane)); const int tid = wave * 64 + lane; (void)tid;

    const bf16* OS = (const bf16*)(F.ws + WS_Y); const bf16* GH = (const bf16*)(F.ws + WS_R1 + 256 * MiB); bf16* OB = (bf16*)(F.ws + WS_OB);
    const int gw = F.vcu * NWAVES + wave, NGW = F.G * NWAVES;
    const f32x4 gn = *(const f32x4*)(gnorm + 4 * (lane & 31));
#pragma unroll 1
    for (int m = gw; m < T; m += 2 * NGW) {
        int mr[2]; mr[0] = m; mr[1] = (m + NGW < T) ? m + NGW : m;
        unsigned long long vq[2][8]; unsigned long long gq[2][8];
#pragma unroll
        for (int r = 0; r < 2; ++r) { const GAS unsigned long long* orow = (const GAS unsigned long long*)(OS + (size_t)mr[r] * D) + lane; const GAS unsigned long long* grow = (const GAS unsigned long long*)(GH + (size_t)mr[r] * D) + lane;
#pragma unroll
            for (int j = 0; j < 8; ++j) { vq[r][j] = orow[64 * j]; gq[r][j] = grow[64 * j]; } }
#pragma unroll
        for (int r = 0; r < 2; ++r) { GAS unsigned long long* o8 = (GAS unsigned long long*)(OB + (size_t)mr[r] * D) + lane;
#pragma unroll
            for (int j = 0; j < 8; ++j) { const unsigned x0 = (unsigned)vq[r][j], x1 = (unsigned)(vq[r][j] >> 32); const f32x4 x = (f32x4){bflo(x0), bfhi(x0), bflo(x1), bfhi(x1)};
                float ss = (x.x * x.x + x.y * x.y) + (x.z * x.z + x.w * x.w);
#pragma unroll
                for (int o = 1; o < 32; o <<= 1) ss += __shfl_xor(ss, o);
                const float rs = 1.0f / sqrtf(ss * (1.0f / HD) + RMS_EPS);
                const unsigned g0 = (unsigned)gq[r][j], g1 = (unsigned)(gq[r][j] >> 32);
                o8[64 * j] = (unsigned long long)pk2(x.x * rs * gn.x * bflo(g0), x.y * rs * gn.y * bfhi(g0)) | ((unsigned long long)pk2(x.z * rs * gn.z * bflo(g1), x.w * rs * gn.w * bfhi(g1)) << 32); } }
    }
}

__device__ __forceinline__ void ln_route_phase(Frame& F, int layer, const float* lng, const float* lnb, const float* wrg, const float* brg, const float* wre, const float* bre) {
    const int wave = F.wave; int lane = lane_id(); asm volatile("" : "+v"(lane)); const int tid = wave * 64 + lane; (void)tid;

    const bf16* Y = (const bf16*)(F.ws + WS_Y);
    const int NGW = F.G * NWAVES;
    typedef short bf16x8r __attribute__((ext_vector_type(8)));
    LAS unsigned char* LH = F.lds + RING_OFF; LAS unsigned char* LL = LH + 65536;
    const bf16* WH = (const bf16*)(F.ws + WS_WR) + (size_t)layer * 2 * 48 * D; const bf16* WL = WH + 48 * D;
    const int l16 = lane & 15, kq = lane >> 4;
#define LNR_BAR() do { asm volatile("s_waitcnt lgkmcnt(0)" ::: "memory"); __builtin_amdgcn_s_barrier(); asm volatile("" ::: "memory"); } while (0)
    int it = 0;
#pragma unroll 1
    for (int mb = F.vcu * NWAVES; mb < T; mb += 2 * NGW, ++it) {
        const int m = mb + wave; bool ok[2]; ok[0] = m < T; ok[1] = m + NGW < T;
        int mr[2]; mr[0] = ok[0] ? m : T - 1; mr[1] = ok[1] ? m + NGW : T - 1;
        f32x4 v[2][8]; float s[2];
#pragma unroll
        for (int r = 0; r < 2; ++r) { const GAS unsigned long long* yr = (const GAS unsigned long long*)(Y + (size_t)mr[r] * D) + lane; s[r] = 0.f;
#pragma unroll
            for (int j = 0; j < 8; ++j) { const unsigned long long yq = yr[64 * j]; const unsigned y0 = (unsigned)yq, y1 = (unsigned)(yq >> 32); v[r][j] = (f32x4){bflo(y0), bfhi(y0), bflo(y1), bfhi(y1)}; } }
#pragma unroll
        for (int r = 0; r < 2; ++r) {
#pragma unroll
            for (int j = 0; j < 8; ++j) s[r] += (v[r][j].x + v[r][j].y) + (v[r][j].z + v[r][j].w); }
        float mean[2], s2[2], rstd[2];
#pragma unroll
        for (int r = 0; r < 2; ++r) { mean[r] = wave_sum(s[r]) * (1.0f / D); s2[r] = 0.f;
#pragma unroll
            for (int j = 0; j < 8; ++j) { v[r][j] = v[r][j] - mean[r]; s2[r] += (v[r][j].x * v[r][j].x + v[r][j].y * v[r][j].y) + (v[r][j].z * v[r][j].z + v[r][j].w * v[r][j].w); } }
#pragma unroll
        for (int r = 0; r < 2; ++r) rstd[r] = 1.0f / sqrtf(wave_sum(s2[r]) * (1.0f / D) + LN_EPS);
#pragma unroll
        for (int j = 0; j < 8; ++j) { const f32x4 g4 = ((const f32x4*)lng)[lane + 64 * j], b4 = ((const f32x4*)lnb)[lane + 64 * j];
#pragma unroll
            for (int r = 0; r < 2; ++r) { v[r][j] = v[r][j] * rstd[r] * g4 + b4;
                if (ok[r]) ((GAS unsigned*)(F.ws + WS_XB8 + (size_t)mr[r] * D) + lane)[64 * j] = pk4_fp8(v[r][j].x, v[r][j].y, v[r][j].z, v[r][j].w);
                {
                    const unsigned h0 = pk2(v[r][j].x, v[r][j].y), h1 = pk2(v[r][j].z, v[r][j].w);
                    const unsigned l0 = pk2(v[r][j].x - bflo(h0), v[r][j].y - bfhi(h0)), l1 = pk2(v[r][j].z - bflo(h1), v[r][j].w - bfhi(h1));
                    const int rho = r * 8 + wave, ch = (lane >> 1) + 32 * j, addr = rho * 4096 + ((ch ^ rho) << 4) + (lane & 1) * 8;
                    *(LAS unsigned long long*)(LH + addr) = (unsigned long long)h0 | ((unsigned long long)h1 << 32);
                    *(LAS unsigned long long*)(LL + addr) = (unsigned long long)l0 | ((unsigned long long)l1 << 32); } } }
        LNR_BAR();
        f32x4 acc[3];
#pragma unroll
        for (int ct = 0; ct < 3; ++ct) acc[ct] = (f32x4){0.f, 0.f, 0.f, 0.f};
#pragma unroll 4
        for (int ks = 0; ks < 8; ++ks) {
            const int ch = 32 * wave + 4 * ks + kq, aaddr = l16 * 4096 + ((ch ^ l16) << 4), kb = 256 * wave + 32 * ks + 8 * kq;
            const bf16x8r ah = *(const LAS bf16x8r*)(LH + aaddr), al = *(const LAS bf16x8r*)(LL + aaddr);
            bf16x8r bh[3], bl[3];
#pragma unroll
            for (int ct = 0; ct < 3; ++ct) { bh[ct] = *(const GAS bf16x8r*)(WH + (size_t)(ct * 16 + l16) * D + kb); bl[ct] = *(const GAS bf16x8r*)(WL + (size_t)(ct * 16 + l16) * D + kb); }
#pragma unroll
            for (int ct = 0; ct < 3; ++ct) {
                acc[ct] = __builtin_amdgcn_mfma_f32_16x16x32_bf16(ah, bh[ct], acc[ct], 0, 0, 0);
                acc[ct] = __builtin_amdgcn_mfma_f32_16x16x32_bf16(al, bh[ct], acc[ct], 0, 0, 0);
                acc[ct] = __builtin_amdgcn_mfma_f32_16x16x32_bf16(ah, bl[ct], acc[ct], 0, 0, 0); }
        }
        LNR_BAR();
        LAS float* P = (LAS float*)LH;
#pragma unroll
        for (int ct = 0; ct < 3; ++ct)
#pragma unroll
            for (int r = 0; r < 4; ++r) P[(wave * 16 + 4 * kq + r) * 48 + ct * 16 + l16] = acc[ct][r];
        LNR_BAR();
        if (wave == 0) {
            volatile LAS unsigned* lc = (volatile LAS unsigned*)(LH + 32768);
            if (lane < 32) lc[lane] = 0u;
            asm volatile("s_waitcnt lgkmcnt(0)" ::: "memory");
            int ex1 = 0, ex2 = 0; float w1 = 0.f, w2 = 0.f; unsigned k1 = 0u, k2 = 0u;
            const int mrow = (F.vcu * NWAVES + (lane & 7)) + (2 * it + ((lane >> 3) & 1)) * NGW;
            const bool rowok = lane < 16 && mrow < T;
            if (rowok) {
                const int rho = lane;
                float g4[4];
#pragma unroll
                for (int n = 0; n < 4; ++n) { float a = 0.f;
#pragma unroll
                    for (int q = 0; q < 8; ++q) a += P[(q * 16 + rho) * 48 + n];
                    g4[n] = a + brg[n]; }
                const float gmx = fmaxf(fmaxf(g4[0], g4[1]), fmaxf(g4[2], g4[3]));
                const float e0 = __expf(g4[0] - gmx), e1 = __expf(g4[1] - gmx), e2 = __expf(g4[2] - gmx), e3 = __expf(g4[3] - gmx);
                const float gs = (e0 + e1) + (e2 + e3);
                const float p0 = e0 / gs, p1 = e1 / gs, p2 = e2 / gs, p3 = e3 / gs;
                int gi = 0; float gwt = p0; if (p1 > gwt) { gwt = p1; gi = 1; } if (p2 > gwt) { gwt = p2; gi = 2; } if (p3 > gwt) { gwt = p3; gi = 3; }
                float c[8]; float cmx = -__builtin_inff();
#pragma unroll
                for (int n = 0; n < 8; ++n) { const int col = 4 + gi * 8 + n; float a = 0.f;
#pragma unroll
                    for (int q = 0; q < 8; ++q) a += P[(q * 16 + rho) * 48 + col];
                    c[n] = a + bre[gi * 8 + n]; cmx = fmaxf(cmx, c[n]); }
                float es = 0.f;
#pragma unroll
                for (int n = 0; n < 8; ++n) { c[n] = __expf(c[n] - cmx); es += c[n]; }
                int i1 = 0; float q1 = -1.f;
#pragma unroll
                for (int n = 0; n < 8; ++n) { c[n] = c[n] / es; if (c[n] > q1) { q1 = c[n]; i1 = n; } }
                int i2 = 0; float q2 = -1.f;
#pragma unroll
                for (int n = 0; n < 8; ++n) if (n != i1 && c[n] > q2) { q2 = c[n]; i2 = n; }
                const float qs = q1 + q2; w1 = gwt * (q1 / qs); w2 = gwt * (q2 / qs);
                ex1 = gi * 8 + i1; ex2 = gi * 8 + i2;
                k1 = __hip_atomic_fetch_add((LAS unsigned*)(lc + ex1), 1u, __ATOMIC_RELAXED, __HIP_MEMORY_SCOPE_WORKGROUP);
                k2 = __hip_atomic_fetch_add((LAS unsigned*)(lc + ex2), 1u, __ATOMIC_RELAXED, __HIP_MEMORY_SCOPE_WORKGROUP);
            }
            asm volatile("s_waitcnt lgkmcnt(0)" ::: "memory");
            if (lane < 32) { const unsigned n_e = lc[lane]; unsigned b_e = 0u; if (n_e) b_e = __hip_atomic_fetch_add(F.ctl + CW_CNT + (layer * 32 + lane) * 32, n_e, RLX_AGENT); lc[32 + lane] = b_e; }
            asm volatile("s_waitcnt vmcnt(0) lgkmcnt(0)" ::: "memory");
            if (rowok) {
                unsigned* TI = (unsigned*)(F.ws + WS_TI);
                const unsigned s1 = lc[32 + ex1] + k1, sl2 = lc[32 + ex2] + k2;
                v4u t0; t0.x = (unsigned)ex1; t0.y = s1; t0.z = __float_as_uint(w1); t0.w = 0u;
                v4u t1; t1.x = (unsigned)ex2; t1.y = sl2; t1.z = __float_as_uint(w2); t1.w = 0u;
                *(GAS v4u*)(TI + (size_t)mrow * 8) = t0; *(GAS v4u*)(TI + (size_t)mrow * 8 + 4) = t1;
            }
        }
        LNR_BAR();
    }
#undef LNR_BAR
}
__device__ __forceinline__ int moe_tables(Frame& F, int layer) {
    const int wave = F.wave; int lane = lane_id(); asm volatile("" : "+v"(lane)); const int tid = wave * 64 + lane; (void)tid;

    volatile LAS int* tab = (volatile LAS int*)(F.lds + TAB_OFF);
    __syncthreads();
    if (wave == 0) {
        int cnt = 0; if (lane < 32) cnt = (int)__hip_atomic_load(F.ctl + CW_CNT + (layer * 32 + lane) * 32, RLX_AGENT);
        const int nt = (cnt + 255) >> 8;
        int inc = nt;
#pragma unroll
        for (int o = 1; o < 32; o <<= 1) { const int t = __shfl_up(inc, o); if (lane >= o) inc += t; }
        const int base = inc - nt;
        int total = __shfl(inc, 31); if (total > MAXTILES) total = MAXTILES;
        if (lane < 32) { tab[lane] = cnt; tab[32 + lane] = base * 256; for (int t = 0; t < nt; ++t) if (base + t < MAXTILES) tab[128 + base + t] = lane; }
        if (lane == 0) { tab[64] = total * 256; tab[65] = total; }
    }
    __syncthreads();
    return tab[65];
}
__device__ __forceinline__ void dispatch_phase(Frame& F, int layer) {
    const int wave = F.wave; int lane = lane_id(); asm volatile("" : "+v"(lane)); const int tid = wave * 64 + lane; (void)tid;

    (void)moe_tables(F, layer);
    volatile LAS int* tab = (volatile LAS int*)(F.lds + TAB_OFF);
    const unsigned char* XB8 = F.ws + WS_XB8; unsigned char* XG8 = F.ws + WS_R1; const unsigned* TI = (const unsigned*)(F.ws + WS_TI);
    const int gw = F.vcu * NWAVES + wave, NGW = F.G * NWAVES;
#pragma unroll 1
    for (int m = gw; m < T; m += NGW) {
        const v4u t0 = *(const GAS v4u*)(TI + (size_t)m * 8), t1 = *(const GAS v4u*)(TI + (size_t)m * 8 + 4);
        const int r1 = tab[32 + (int)t0.x] + (int)t0.y, r2 = tab[32 + (int)t1.x] + (int)t1.y;
        const GAS v4u* src = (const GAS v4u*)(XB8 + (size_t)m * D) + lane; GAS v4u* d1 = (GAS v4u*)(XG8 + (size_t)r1 * D) + lane; GAS v4u* d2 = (GAS v4u*)(XG8 + (size_t)r2 * D) + lane;
#pragma unroll
        for (int j = 0; j < 2; ++j) { const v4u w = src[64 * j]; d1[64 * j] = w; d2[64 * j] = w; }
    }
}
__device__ __forceinline__ void ln_ffn_phase(Frame& F, int layer, const float* mixg, const float* mixb, const float* lng, const float* lnb, float* out_f, int write_xb  ) {
    const int wave = F.wave; int lane = lane_id(); asm volatile("" : "+v"(lane)); const int tid = wave * 64 + lane; (void)tid;

    (void)moe_tables(F, layer);
    volatile LAS int* tab = (volatile LAS int*)(F.lds + TAB_OFF);
    bf16* XB = (bf16*)(F.ws + WS_XB); bf16* XL = (bf16*)(F.ws + WS_XL); const unsigned char* YR = F.ws + WS_R1 + 160 * MiB; const unsigned* TI = (const unsigned*)(F.ws + WS_TI);
    const int gw = F.vcu * NWAVES + wave, NGW = F.G * NWAVES;
#pragma unroll 1
    for (int m = gw; m < T; m += 2 * NGW) {
        int mr[2]; mr[0] = m; mr[1] = (m + NGW < T) ? m + NGW : m; const bool two = mr[1] != m;
        v4u t0[2], t1[2];
#pragma unroll
        for (int r = 0; r < 2; ++r) { t0[r] = *(const GAS v4u*)(TI + (size_t)mr[r] * 8); t1[r] = *(const GAS v4u*)(TI + (size_t)mr[r] * 8 + 4); }
        f32x4 v[2][8];
#pragma unroll
        for (int r = 0; r < 2; ++r) { const GAS unsigned long long* yr = (const GAS unsigned long long*)((const bf16*)(F.ws + WS_Y) + (size_t)mr[r] * D) + lane;
#pragma unroll
            for (int j = 0; j < 8; ++j) { const unsigned long long yq = yr[64 * j]; const unsigned y0 = (unsigned)yq, y1 = (unsigned)(yq >> 32); v[r][j] = (f32x4){bflo(y0), bfhi(y0), bflo(y1), bfhi(y1)}; } }
#pragma unroll
        for (int r = 0; r < 2; ++r) { float sy = 0.f;
#pragma unroll
            for (int j = 0; j < 8; ++j) sy += (v[r][j].x + v[r][j].y) + (v[r][j].z + v[r][j].w);
            const float my = wave_sum(sy) * (1.0f / D); float qy = 0.f;
#pragma unroll
            for (int j = 0; j < 8; ++j) { v[r][j] = v[r][j] - my; qy += (v[r][j].x * v[r][j].x + v[r][j].y * v[r][j].y) + (v[r][j].z * v[r][j].z + v[r][j].w * v[r][j].w); }
            const float ry = 1.0f / sqrtf(wave_sum(qy) * (1.0f / D) + LN_EPS);
#pragma unroll
            for (int j = 0; j < 8; ++j) { const f32x4 g4 = ((const f32x4*)mixg)[lane + 64 * j], b4 = ((const f32x4*)mixb)[lane + 64 * j]; v[r][j] = v[r][j] * ry * g4 + b4; } }
        float s[2];
#pragma unroll
        for (int r = 0; r < 2; ++r) {
            const unsigned e1 = t0[r].x, sl1 = t0[r].y, wz1 = t0[r].z, e2 = t1[r].x, sl2 = t1[r].y, wz2 = t1[r].z;
            const int r1 = tab[32 + (int)e1] + (int)sl1, r2 = tab[32 + (int)e2] + (int)sl2;
            const float w1 = __uint_as_float(wz1) * (1.0f / Y8_SCALE), w2 = __uint_as_float(wz2) * (1.0f / Y8_SCALE);
            const GAS int* y1 = (const GAS int*)(YR + (size_t)r1 * D) + lane; const GAS int* y2 = (const GAS int*)(YR + (size_t)r2 * D) + lane;
            s[r] = 0.f;
#pragma unroll
            for (int j = 0; j < 8; ++j) { const int a = y1[64 * j], bq = y2[64 * j];
                typedef float f32x2_ __attribute__((ext_vector_type(2)));
                const f32x2_ al = __builtin_amdgcn_cvt_pk_f32_fp8(a, false), ah = __builtin_amdgcn_cvt_pk_f32_fp8(a, true), bl = __builtin_amdgcn_cvt_pk_f32_fp8(bq, false), bh = __builtin_amdgcn_cvt_pk_f32_fp8(bq, true);
                f32x4 mm; mm.x = w1 * al.x + w2 * bl.x; mm.y = w1 * al.y + w2 * bl.y; mm.z = w1 * ah.x + w2 * bh.x; mm.w = w1 * ah.y + w2 * bh.y;
                v[r][j] = v[r][j] * ALPHA + mm; s[r] += (v[r][j].x + v[r][j].y) + (v[r][j].z + v[r][j].w); } }
        float mean[2], s2[2], rstd[2];
#pragma unroll
        for (int r = 0; r < 2; ++r) { mean[r] = wave_sum(s[r]) * (1.0f / D); s2[r] = 0.f;
#pragma unroll
            for (int j = 0; j < 8; ++j) { v[r][j] = v[r][j] - mean[r]; s2[r] += (v[r][j].x * v[r][j].x + v[r][j].y * v[r][j].y) + (v[r][j].z * v[r][j].z + v[r][j].w * v[r][j].w); } }
#pragma unroll
        for (int r = 0; r < 2; ++r) rstd[r] = 1.0f / sqrtf(wave_sum(s2[r]) * (1.0f / D) + LN_EPS);
#pragma unroll
        for (int j = 0; j < 8; ++j) { const f32x4 g4 = ((const f32x4*)lng)[lane + 64 * j], b4 = ((const f32x4*)lnb)[lane + 64 * j];
#pragma unroll
            for (int r = 0; r < 2; ++r) { const f32x4 o = v[r][j] * rstd[r] * g4 + b4;
                if (r == 0 || two) {
                    if (write_xb == 0) ((GAS f32x4*)(out_f + (size_t)mr[r] * D) + lane)[64 * j] = o;
                    else { const unsigned h0 = pk2(o.x, o.y), h1 = pk2(o.z, o.w);
                        ((GAS unsigned long long*)(XB + (size_t)mr[r] * D) + lane)[64 * j] = (unsigned long long)h0 | ((unsigned long long)h1 << 32);
                        const unsigned l0 = pk2(o.x - bflo(h0), o.y - bfhi(h0)), l1 = pk2(o.z - bflo(h1), o.w - bfhi(h1));
                        ((GAS unsigned long long*)(XL + (size_t)mr[r] * D) + lane)[64 * j] = (unsigned long long)l0 | ((unsigned long long)l1 << 32); }
                    if (write_xb == 2) ((GAS unsigned*)(F.ws + WS_XB8 + (size_t)mr[r] * D) + lane)[64 * j] = pk4_fp8(o.x, o.y, o.z, o.w); } } }
    }
}

constexpr int PH_PER_LAYER_ = 9;
struct Args { const float* in[18]; float* out; unsigned char* ws; int ph_lo, ph_hi, use_bar, pad; };

constexpr int PH_PER_LAYER = 9, N_PHASES = 1 + DEPTH * PH_PER_LAYER;
#define IN(k) (lo <= (k) && (k) < hi)
#define SEAM(k) do { if ((k) + 1 < hi) xcd_barrier(bar, F.wave); } while (0)
template <int L> __device__ __forceinline__ void run_layer(Frame& F, const Args& args, const XcdBarrier& bar, const int lo, const int hi) {
    const float* const* in = args.in;
    bf16* XB = (bf16*)(F.ws + WS_XB); float* X = (float*)(F.ws + WS_X); float* Y = (float*)(F.ws + WS_Y); bf16* OB = (bf16*)(F.ws + WS_OB);
    bf16* R1 = (bf16*)(F.ws + WS_R1); bf16* HBUF = (bf16*)(F.ws + WS_H);
        constexpr int l = L; constexpr int base = 1 + l * PH_PER_LAYER, jj = l >> 1; constexpr bool hg = (l & 1) != 0;
        if (!(base < hi && lo < base + PH_PER_LAYER)) return;
#ifndef NO_G0
        if (IN(base + 0)) {
#ifndef NO_G0A
            if constexpr (!hg) {
                pg8::StaticOrder S; S.init((const bf16*)(F.ws + WS_XB8), (const bf16*)(F.ws + WS_WQKV + (size_t)jj * NQKV * D), T, NQKV, D / 2, F.G, (int)blockIdx.x);
                pg8::EpiBf16 E{R1, D, D, (size_t)T * D, 1.0f / W8_SCALE, (float*)(F.ws + WS_KS) + (size_t)jj * (BATCH * NH * NBLK * HD)};
                pg8::gemm_phase<pg8::EpiBf16, pg8::StaticOrder, true, true, true>(F.lds + RING_OFF, D / 2, S, E, F.wave);
            }
#endif
#ifndef NO_G0B
            if constexpr (hg) {
                pg8::StaticOrder S; S.init(XB, (const bf16*)(F.ws + WS_WHIN) + (size_t)jj * NHIN * D, T, NHIN, D, F.G, (int)blockIdx.x);
                pg8::EpiHgrnIn E{R1, (float*)(F.ws + WS_R1 + 64 * MiB), OB  , in[5], in[5] + D, jj, D};
                pg8::gemm_phase<pg8::EpiHgrnIn, pg8::StaticOrder, true, true>(F.lds + RING_OFF, D, S, E, F.wave);
            }
#endif
            SEAM(base + 0);
        }
#endif
        if constexpr (hg) { if (IN(base + 1)) {
 scan_mfma_phase(F);
 SEAM(base + 1); } }
        if (IN(base + 2)) {
#ifndef NO_ATTN
 if constexpr (!hg) {
 attn_mfma_phase(F, jj);
 }
#endif
#ifndef NO_GN
 if constexpr (hg) gatenorm_phase(F, in[4] + (size_t)jj * HD);
#endif
 SEAM(base + 2); }
#ifndef NO_G3
        if (IN(base + 3)) {
            if constexpr (!hg) {
                pg8::StaticOrder S; S.init((const bf16*)(F.ws + WS_OB), (const bf16*)(F.ws + WS_WOM + (size_t)jj * D * D), T, D, D / 2, F.G, (int)blockIdx.x);
                pg8::EpiResB16 E{l == 0 ? in[0] : (const float*)nullptr, XB, (const bf16*)(F.ws + WS_XL), (bf16*)Y, D, ALPHA, 1.0f / (W8_SCALE * O8_SCALE)};
                pg8::gemm_phase<pg8::EpiResB16, pg8::StaticOrder, true, true, true>(F.lds + RING_OFF, D / 2, S, E, F.wave);
            } else {
                pg8::StaticOrder S; S.init(OB, (const bf16*)(F.ws + WS_WOH) + (size_t)jj * D * D, T, D, D, F.G, (int)blockIdx.x);
                pg8::EpiResB16 E{l == 0 ? in[0] : (const float*)nullptr, XB, (const bf16*)(F.ws + WS_XL), (bf16*)Y, D, ALPHA, 1.0f};
                pg8::gemm_phase<pg8::EpiResB16, pg8::StaticOrder, true, true>(F.lds + RING_OFF, D, S, E, F.wave);
            }
            SEAM(base + 3);
        }
#endif
        #ifndef NO_LNR
        if (IN(base + 4)) { ln_route_phase(F, l, in[7] + (size_t)l * D, in[8] + (size_t)l * D, in[9] + (size_t)l * D * 4, in[10] + l * 4, in[11] + (size_t)l * 4 * D * 8, in[12] + l * 32); SEAM(base + 4); }
#endif
        if (IN(base + 5)) { dispatch_phase(F, l); SEAM(base + 5); }
#ifndef NO_G6
        if (IN(base + 6)) {
            const int ntl = moe_tables(F, l);
            pg8::MoeOrder S{R1, (const bf16*)(F.ws + WS_W1 + (size_t)l * 32 * 1024 * D), D / 2, 4, (size_t)1024 * D, ntl, F.G, F.vcu, (const LAS int*)(F.lds + TAB_OFF) + 128};
            pg8::EpiMoe1 E{(unsigned char*)HBUF, DEXP, H8_SCALE, 1.0f / W8_SCALE};
            pg8::gemm_phase<pg8::EpiMoe1, pg8::MoeOrder, true, true, true>(F.lds + RING_OFF, D / 2, S, E, F.wave);
            if constexpr (l + 1 < DEPTH) {
                const int total = ntl * 4, rem = total % F.G;
                if (F.vcu >= rem) conv_tiles<1>(F, in, F.vcu - rem, F.G - rem, CV_NDEF, l + 1, F.wave * 64 + lane_id());
            }
            SEAM(base + 6);
        }
#endif
#ifndef NO_G7
        if (IN(base + 7)) {
            const int ntl = moe_tables(F, l);
            pg8::MoeOrder S{HBUF, (const bf16*)(F.ws + WS_W2 + (size_t)l * 32 * D * DEXP), DEXP / 2, 8, (size_t)D * DEXP, ntl, F.G, F.vcu, (const LAS int*)(F.lds + TAB_OFF) + 128};
            pg8::EpiF8 E{F.ws + WS_R1 + 160 * MiB, D, Y8_SCALE / (W8_SCALE * H8_SCALE)};
            pg8::gemm_phase<pg8::EpiF8, pg8::MoeOrder, true, true, true>(F.lds + RING_OFF, DEXP / 2, S, E, F.wave);
            SEAM(base + 7);
        }
#endif
        #ifndef NO_LNF
        if (IN(base + 8)) { ln_ffn_phase(F, l, in[7] + (size_t)l * D, in[8] + (size_t)l * D, in[16] + (size_t)l * D, in[17] + (size_t)l * D, args.out, l == DEPTH - 1 ? 0 : (hg ? 2 : 1)); SEAM(base + 8); }
#endif
    }
__global__ void __launch_bounds__(NTHR, 2) mk_fwd(Args args) {
    extern __shared__ __attribute__((aligned(16))) unsigned char lds[];
    Frame F;
    F.lds = (LAS unsigned char*)lds;
    F.MISC = (volatile LAS unsigned*)(F.lds + MISC_OFF);
    F.wave = __builtin_amdgcn_readfirstlane((int)(threadIdx.x >> 6));
    F.G = gridDim.x; { const int bx = blockIdx.x; F.vcu = (F.G % 8 == 0) ? (bx % 8) * (F.G / 8) + bx / 8 : bx; }
    F.ws = args.ws; F.ctl = (gu32*)(args.ws + WS_CTL);
    for (int u = F.wave * 64 + lane_id(); u < (LDS_BYTES - LDSCTL_OFF) / 4; u += NTHR) ((LAS unsigned*)(F.lds + LDSCTL_OFF))[u] = 0u;
    __syncthreads();
    XcdBarrier bar; bar.bar = (unsigned*)(F.ctl + CW_BAR); bar.x = 0; bar.st = nullptr;
    if (args.use_bar) bar = xcd_barrier_post((unsigned*)(F.ctl + CW_BAR), F.MISC + 8, F.wave == 0 && lane_id() == 0);
    const int lo = args.ph_lo, hi = args.ph_hi;
    const float* const* in = args.in;
    bf16* XB = (bf16*)(F.ws + WS_XB); float* X = (float*)(F.ws + WS_X); float* Y = (float*)(F.ws + WS_Y); bf16* OB = (bf16*)(F.ws + WS_OB);
    bf16* R1 = (bf16*)(F.ws + WS_R1); bf16* HBUF = (bf16*)(F.ws + WS_H);

    #ifndef NO_P0
    if (IN(0)) { p0_prologue(F, in); SEAM(0); }
#endif

    run_layer<0>(F, args, bar, lo, hi); run_layer<1>(F, args, bar, lo, hi); run_layer<2>(F, args, bar, lo, hi); run_layer<3>(F, args, bar, lo, hi);
#undef IN
#undef SEAM
}

#ifndef MK_N_LAUNCHES
#define MK_N_LAUNCHES 1
#endif
extern "C" void kernel_launch(void* const* d_in, const int* in_sizes, int n_in, void* d_out, int out_size, void* d_ws, size_t ws_size, hipStream_t stream) {
    static int grid = 0;
    if (grid == 0) {
        if (n_in != 18 || in_sizes[0] != T * D || out_size != T * D || ws_size < WS_END) { fprintf(stderr, "kernel_launch: unexpected shapes (n_in %d, in0 %d, out %d, ws %zu); nothing launched\n", n_in, n_in > 0 ? in_sizes[0] : -1, out_size, ws_size); grid = -1; return; }
        int dev = 0, cus = 0, per_cu = 0;
        if (hipGetDevice(&dev) != hipSuccess || hipDeviceGetAttribute(&cus, hipDeviceAttributeMultiprocessorCount, dev) != hipSuccess) { fprintf(stderr, "kernel_launch: device query failed\n"); grid = -1; return; }
        if (hipFuncSetAttribute((const void*)mk_fwd, hipFuncAttributeMaxDynamicSharedMemorySize, LDS_BYTES) != hipSuccess) { fprintf(stderr, "kernel_launch: hipFuncSetAttribute failed\n"); grid = -1; return; }
        if (hipOccupancyMaxActiveBlocksPerMultiprocessor(&per_cu, (const void*)mk_fwd, NTHR, LDS_BYTES) != hipSuccess || per_cu < 1) fprintf(stderr, "kernel_launch: occupancy query reports %d\n", per_cu);
        (void)hipGetLastError();
        grid = cus;
    }
    if (grid < 0) return;
    if (hipMemsetAsync((char*)d_ws + WS_CTL, 0, CTL_ZERO_BYTES, stream) != hipSuccess) { fprintf(stderr, "kernel_launch: memset failed\n"); return; }
    Args a{};
    for (int i = 0; i < 18; ++i) a.in[i] = (const float*)d_in[i];
    a.out = (float*)d_out; a.ws = (unsigned char*)d_ws; a.pad = 0;
#if MK_N_LAUNCHES == 1
    a.ph_lo = 0; a.ph_hi = N_PHASES; a.use_bar = 1;
    hipLaunchKernelGGL(mk_fwd, dim3(grid), dim3(NTHR), LDS_BYTES, stream, a);
#else
    for (int p = 0; p < N_PHASES; ++p) { a.ph_lo = p; a.ph_hi = p + 1; a.use_bar = 0; hipLaunchKernelGGL(mk_fwd, dim3(grid), dim3(NTHR), LDS_BYTES, stream, a); }
#endif
    const hipError_t le = hipPeekAtLastError();
    if (le != hipSuccess) fprintf(stderr, "kernel_launch: launch failed: %s\n", hipGetErrorName(le));
}
```

```cpp
#include <hip/hip_runtime.h>
#include <cstdio>
#include <cstdint>
__device__ __forceinline__ int lane_id() { int l; asm volatile("v_mbcnt_lo_u32_b32 %0, -1, 0\n\tv_mbcnt_hi_u32_b32 %0, -1, %0" : "=v"(l)); return l; }
namespace pg8 {
using ::lane_id;
#define PG8_LAS __attribute__((address_space(3)))
typedef unsigned short bf16_t;
typedef short bf16x8 __attribute__((ext_vector_type(8)));
typedef float f32x4 __attribute__((ext_vector_type(4)));
typedef unsigned u32x4 __attribute__((ext_vector_type(4)));
typedef int i32x4 __attribute__((ext_vector_type(4)));
typedef int i32x8 __attribute__((ext_vector_type(8)));
constexpr int BM = 256, BK = 64, HALF = 128, HTB = HALF * BK * 2  , STAGE_BYTES = 8 * HTB, NXCD = 8, WGM = 8;

__host__ __device__ __forceinline__ int lds_byte(int r, int c) { const int st = (r >> 4) * 2 + (c >> 5), rr = r & 15, cc = c & 31, ob = rr * 64 + cc * 2; return st * 1024 + (ob ^ (((ob >> 9) & 1) << 5)); }
__host__ __device__ __forceinline__ void stage_rc(int b, int& R, int& C) { const int st = b / 1024, sb = b % 1024, swz = sb ^ (((sb >> 9) & 1) << 5); R = (st >> 1) * 16 + swz / 64; C = (st & 1) * 32 + (swz % 64) / 2; }
__host__ __device__ __forceinline__ int perm32(int rho) { const int n = rho >> 4, i = rho & 15; return 8 * (i >> 2) + 4 * n + (i & 3); }

struct Unit { int pm, pn; };

struct StaticOrder {
    const bf16_t* A; const bf16_t* Bt; int K;
    int nM, nN, nwg, G, c;
    __host__ __device__ void init(const bf16_t* A_, const bf16_t* Bt_, int M, int N, int K_, int G_, int c_) { A = A_; Bt = Bt_; K = K_; nM = M / BM; nN = N / BM; nwg = nM * nN; G = G_; c = c_; }
    __device__ __forceinline__ const char* a_ptr(const Unit& u) const { return (const char*)A + (size_t)u.pm * (size_t)(BM * 2) * K; }
    __device__ __forceinline__ const char* b_ptr(const Unit& u) const { return (const char*)Bt + (size_t)u.pn * (size_t)(BM * 2) * K; }
    __host__ __device__ bool next(int i, Unit& u) const {
        const long L = (long)i * G + c; if (L >= nwg) return false;
        int wgid = (int)L; { const int q = nwg / NXCD, r = nwg % NXCD, xcd = wgid % NXCD, off = wgid / NXCD; wgid = (xcd < r ? xcd * (q + 1) : r * (q + 1) + (xcd - r) * q) + off; }
        const int nig = WGM * nN, gid = wgid / nig, fm = gid * WGM, gsz = (nM - fm) < WGM ? (nM - fm) : WGM;
        u.pm = fm + ((wgid % nig) % gsz); u.pn = (wgid % nig) / gsz; return true;
    }
    __device__ __forceinline__ void a_ready(const Unit&) const {}
    __device__ __forceinline__ void done(const Unit&) const {}
};

struct MoeOrder {
    const bf16_t* A; const bf16_t* Bt; int K; int npn; size_t bstride; int ntiles, G, c; const PG8_LAS int* tileExp;
    __device__ __forceinline__ bool next(int i, Unit& u) const { const int L = i * G + c; if (L >= ntiles * npn) return false; u.pm = L / npn; u.pn = L - u.pm * npn; return true; }
    __device__ __forceinline__ const char* a_ptr(const Unit& u) const { return (const char*)A + (size_t)u.pm * (size_t)(BM * 2) * K; }
    __device__ __forceinline__ const char* b_ptr(const Unit& u) const { const int e = __builtin_amdgcn_readfirstlane(tileExp[u.pm]); return (const char*)Bt + (size_t)e * bstride + (size_t)u.pn * (size_t)(BM * 2) * K; }
    __device__ __forceinline__ void a_ready(const Unit&) const {}
    __device__ __forceinline__ void done(const Unit&) const {}
};

__device__ __forceinline__ unsigned cvt_pk_bf16(float lo, float hi) { unsigned r; asm volatile("v_cvt_pk_bf16_f32 %0, %1, %2" : "=v"(r) : "v"(lo), "v"(hi)); return r; }
__device__ __forceinline__ float silu_f(float v) { return v * __builtin_amdgcn_rcpf(1.0f + __expf(-v)); }

struct EpiBf16 {
    static constexpr bool PERM = true, AFTER_DRAIN = false;
    bf16_t* O; int ldc; int split_cols; size_t split_stride; float scale; float* ksum;
    __device__ __forceinline__ void operator()(const f32x4 (&acc)[2][2][4][2], const Unit& u, int wr, int wc, int fr, int fq) const {
        int row0 = u.pm * BM + wr * 64 + fr; asm volatile("" : "+v"(row0));
        int colt = u.pn * BM; bf16_t* base = O;
        if (split_cols) { const int t = colt / split_cols; base += (size_t)t * split_stride; colt -= t * split_cols; }
        const int col0 = colt + wc * 32 + 8 * fq;
#pragma unroll
        for (int ai = 0; ai < 2; ++ai)
#pragma unroll
            for (int m = 0; m < 4; ++m) { bf16_t* rowp = base + (size_t)(row0 + ai * HALF + m * 16) * ldc + col0;
#pragma unroll
                for (int bj = 0; bj < 2; ++bj) { const f32x4 v0 = acc[ai][bj][m][0] * scale, v1 = acc[ai][bj][m][1] * scale;
                    u32x4 w; w.x = cvt_pk_bf16(v0[0], v0[1]); w.y = cvt_pk_bf16(v0[2], v0[3]); w.z = cvt_pk_bf16(v1[0], v1[1]); w.w = cvt_pk_bf16(v1[2], v1[3]);
                    *(u32x4*)(rowp + bj * HALF) = w; } }
        if (ksum != nullptr && split_cols != 0 && (u.pn * BM) / split_cols == 1) {
            const int colk0 = u.pn * BM - split_cols + wc * 32 + 8 * ((lane_id() >> 4) & 3);
#pragma unroll
            for (int bj = 0; bj < 2; ++bj)
#pragma unroll
                for (int n = 0; n < 2; ++n)
#pragma unroll
                    for (int j = 0; j < 4; ++j) { float cs = 0.f;
#pragma unroll
                        for (int ai = 0; ai < 2; ++ai)
#pragma unroll
                            for (int m = 0; m < 4; ++m) cs += acc[ai][bj][m][n][j];
                        cs += __shfl_xor(cs, 1); cs += __shfl_xor(cs, 2); cs += __shfl_xor(cs, 4); cs += __shfl_xor(cs, 8);
                        const int col = colk0 + bj * HALF + 4 * n + j;
                        if ((lane_id() & 15) == 0) atomicAdd(ksum + ((size_t)(((u.pm >> 4) * 16 + (col >> 7)) * 16 + (u.pm & 15))) * 128 + (col & 127), cs * scale); }
        }
    }
};
struct EpiF8 {
    static constexpr bool PERM = true, AFTER_DRAIN = false;
    unsigned char* O; int ldc; float scale;
    __device__ __forceinline__ void operator()(const f32x4 (&acc)[2][2][4][2], const Unit& u, int wr, int wc, int fr, int fq) const {
        int row0 = u.pm * BM + wr * 64 + fr; asm volatile("" : "+v"(row0)); const int col0 = u.pn * BM + wc * 32 + 8 * fq;
#pragma unroll
        for (int ai = 0; ai < 2; ++ai)
#pragma unroll
            for (int m = 0; m < 4; ++m) { unsigned char* rowp = O + (size_t)(row0 + ai * HALF + m * 16) * ldc + col0;
#pragma unroll
                for (int bj = 0; bj < 2; ++bj) { f32x4 v0 = acc[ai][bj][m][0] * scale, v1 = acc[ai][bj][m][1] * scale;
#pragma unroll
                    for (int j = 0; j < 4; ++j) { v0[j] = __builtin_amdgcn_fmed3f(v0[j], -448.f, 448.f); v1[j] = __builtin_amdgcn_fmed3f(v1[j], -448.f, 448.f); }
                    int w0 = __builtin_amdgcn_cvt_pk_fp8_f32(v0[0], v0[1], 0, false); w0 = __builtin_amdgcn_cvt_pk_fp8_f32(v0[2], v0[3], w0, true);
                    int w1 = __builtin_amdgcn_cvt_pk_fp8_f32(v1[0], v1[1], 0, false); w1 = __builtin_amdgcn_cvt_pk_fp8_f32(v1[2], v1[3], w1, true);
                    typedef int i32x2_ __attribute__((ext_vector_type(2)));
                    *(i32x2_*)(rowp + bj * HALF) = (i32x2_){w0, w1}; } }
    }
};
struct EpiResB16 {
    static constexpr bool PERM = true, AFTER_DRAIN = false;
    const float* res; const bf16_t* rhi; const bf16_t* rlo; bf16_t* Y; int ldc; float alpha, scale;
    __device__ __forceinline__ void operator()(const f32x4 (&acc)[2][2][4][2], const Unit& u, int wr, int wc, int fr, int fq) const {
        int row0 = u.pm * BM + wr * 64 + fr; asm volatile("" : "+v"(row0)); const int col0 = u.pn * BM + wc * 32 + 8 * fq;
#pragma unroll
        for (int ai = 0; ai < 2; ++ai)
#pragma unroll
            for (int m = 0; m < 4; ++m) { const size_t off = (size_t)(row0 + ai * HALF + m * 16) * ldc + col0;
#pragma unroll
                for (int bj = 0; bj < 2; ++bj) { f32x4 r0, r1;
                    if (res) { r0 = *(const f32x4*)(res + off + bj * HALF); r1 = *(const f32x4*)(res + off + bj * HALF + 4); }
                    else { const u32x4 h = *(const u32x4*)(rhi + off + bj * HALF), lw = *(const u32x4*)(rlo + off + bj * HALF);
                        r0 = (f32x4){__uint_as_float(h.x << 16) + __uint_as_float(lw.x << 16), __uint_as_float(h.x & 0xffff0000u) + __uint_as_float(lw.x & 0xffff0000u), __uint_as_float(h.y << 16) + __uint_as_float(lw.y << 16), __uint_as_float(h.y & 0xffff0000u) + __uint_as_float(lw.y & 0xffff0000u)};
                        r1 = (f32x4){__uint_as_float(h.z << 16) + __uint_as_float(lw.z << 16), __uint_as_float(h.z & 0xffff0000u) + __uint_as_float(lw.z & 0xffff0000u), __uint_as_float(h.w << 16) + __uint_as_float(lw.w << 16), __uint_as_float(h.w & 0xffff0000u) + __uint_as_float(lw.w & 0xffff0000u)}; }
                    const f32x4 o0 = acc[ai][bj][m][0] * scale + r0 * alpha, o1 = acc[ai][bj][m][1] * scale + r1 * alpha;
                    u32x4 w; w.x = cvt_pk_bf16(o0[0], o0[1]); w.y = cvt_pk_bf16(o0[2], o0[3]); w.z = cvt_pk_bf16(o1[0], o1[1]); w.w = cvt_pk_bf16(o1[2], o1[3]);
                    *(u32x4*)(Y + off + bj * HALF) = w; }
                asm volatile("" ::: "memory"); }
    }
};
struct EpiHgrnIn {
    static constexpr bool PERM = true, AFTER_DRAIN = false;
    bf16_t* R; float* LF; bf16_t* KK; const float* lbr0; const float* lbr1; int has_lb; int ldc;
    __device__ __forceinline__ void operator()(const f32x4 (&acc)[2][2][4][2], const Unit& u, int wr, int wc, int fr, int fq) const {
        const int row0 = u.pm * BM + wr * 64 + fr; const int type = u.pn >> 3; const int col0 = (u.pn & 7) * BM + wc * 32 + 8 * fq;
        if (type == 1) {
            f32x4 lb[2][2];
#pragma unroll
            for (int bj = 0; bj < 2; ++bj)
#pragma unroll
                for (int n = 0; n < 2; ++n) {
                    if (has_lb) { const f32x4 r0 = *(const f32x4*)(lbr0 + col0 + bj * HALF + 4 * n), r1 = *(const f32x4*)(lbr1 + col0 + bj * HALF + 4 * n);
#pragma unroll
                        for (int j = 0; j < 4; ++j) lb[bj][n][j] = 1.0f / (1.0f + __expf(r0[j] - r1[j])); }
                    else lb[bj][n] = (f32x4){0.f, 0.f, 0.f, 0.f};
                }
#pragma unroll
            for (int ai = 0; ai < 2; ++ai)
#pragma unroll
                for (int m = 0; m < 4; ++m) { float* rowp = LF + (size_t)(row0 + ai * HALF + m * 16) * ldc + col0; bf16_t* kkp = KK + (size_t)(row0 + ai * HALF + m * 16) * ldc + col0;
#pragma unroll
                    for (int bj = 0; bj < 2; ++bj)
#pragma unroll
                        for (int n = 0; n < 2; ++n) { f32x4 o, kq;
#pragma unroll
                            for (int j = 0; j < 4; ++j) { const float sg = __builtin_amdgcn_rcpf(1.0f + __expf(-acc[ai][bj][m][n][j])); const float fg = lb[bj][n][j] + (1.0f - lb[bj][n][j]) * sg; o[j] = __builtin_amdgcn_logf(fg); kq[j] = 1.0f - fg; }
                            *(f32x4*)(rowp + bj * HALF + 4 * n) = o;
                            typedef unsigned u32x2_ __attribute__((ext_vector_type(2)));
                            *(u32x2_*)(kkp + bj * HALF + 4 * n) = (u32x2_){cvt_pk_bf16(kq[0], kq[1]), cvt_pk_bf16(kq[2], kq[3])}; } }
        } else {
            bf16_t* base = (bf16_t*)((char*)R + (type == 0 ? (size_t)0 : ((size_t)(type + 1) << 26)));
#pragma unroll
            for (int ai = 0; ai < 2; ++ai)
#pragma unroll
                for (int m = 0; m < 4; ++m) { bf16_t* rowp = base + (size_t)(row0 + ai * HALF + m * 16) * ldc + col0;
#pragma unroll
                    for (int bj = 0; bj < 2; ++bj) { f32x4 v0 = acc[ai][bj][m][0], v1 = acc[ai][bj][m][1];
                        if (type != 2) {
#pragma unroll
                            for (int j = 0; j < 4; ++j) { v0[j] = silu_f(v0[j]); v1[j] = silu_f(v1[j]); } }
                        u32x4 w; w.x = cvt_pk_bf16(v0[0], v0[1]); w.y = cvt_pk_bf16(v0[2], v0[3]); w.z = cvt_pk_bf16(v1[0], v1[1]); w.w = cvt_pk_bf16(v1[2], v1[3]);
                        *(u32x4*)(rowp + bj * HALF) = w; } }
        }
    }
};
struct EpiMoe1 {
    static constexpr bool PERM = true, AFTER_DRAIN = false;
    unsigned char* Hb; int ldh; float hscale, ascale;
    __device__ __forceinline__ void operator()(const f32x4 (&acc)[2][2][4][2], const Unit& u, int wr, int wc, int fr, int fq) const {
        int row0 = u.pm * BM + wr * 64 + fr; asm volatile("" : "+v"(row0)); const int hid0 = u.pn * 128 + wc * 32 + 8 * fq;
#pragma unroll
        for (int ai = 0; ai < 2; ++ai)
#pragma unroll
            for (int m = 0; m < 4; ++m) { unsigned char* rowp = Hb + (size_t)(row0 + ai * HALF + m * 16) * ldh + hid0;
                f32x4 h0, h1;
#pragma unroll
                for (int j = 0; j < 4; ++j) { h0[j] = __builtin_amdgcn_fmed3f(silu_f(acc[ai][0][m][0][j] * ascale) * (acc[ai][0][m][1][j] * (ascale * hscale)), -448.f, 448.f); h1[j] = __builtin_amdgcn_fmed3f(silu_f(acc[ai][1][m][0][j] * ascale) * (acc[ai][1][m][1][j] * (ascale * hscale)), -448.f, 448.f); }
                int w0 = __builtin_amdgcn_cvt_pk_fp8_f32(h0[0], h0[1], 0, false); w0 = __builtin_amdgcn_cvt_pk_fp8_f32(h0[2], h0[3], w0, true);
                int w1 = __builtin_amdgcn_cvt_pk_fp8_f32(h1[0], h1[1], 0, false); w1 = __builtin_amdgcn_cvt_pk_fp8_f32(h1[2], h1[3], w1, true);
                typedef int i32x2_ __attribute__((ext_vector_type(2)));
                *(i32x2_*)rowp = (i32x2_){w0, w1}; }
    }
};

template <class Epi, class Sched, bool ALIGN_EPI = false, bool SP2 = false, bool F8 = false>
__device__ __forceinline__ void gemm_phase(PG8_LAS unsigned char* lds, const int K, const Sched& S, const Epi& E, const int wave_id) {
    const int lane_ = lane_id(); const int tid_ = wave_id * 64 + lane_;
    const int tid = tid_, wid = wave_id, lane = lane_, wr = wid >> 2, wc = wid & 3, fr = lane & 15, fq = lane >> 4;
    const int nt = K / BK;
    unsigned voffA[2], voffB[2];
#pragma unroll
    for (int i = 0; i < 2; ++i) { int R, C; stage_rc(tid * 16 + i * 8192, R, C); const int Rb = Epi::PERM ? ((R & ~31) + perm32(R & 31)) : R;
        voffA[i] = (unsigned)(R * K + C) * 2u; voffB[i] = (unsigned)(Rb * K + C) * 2u; }
    const size_t kstep = (size_t)(BK * 2);
    const size_t hstep = (size_t)HALF * K * 2;
    const unsigned ldsw = (unsigned)wid * 1024u;
    const int aoff = lds_byte(wr * 64 + fr, fq * 8), boff = lds_byte(wc * 32 + fr, fq * 8);
#define PG8_SA(b, h) (((b) * 2 + (h)) * HTB)
#define PG8_SB(b, h) ((4 + (b) * 2 + (h)) * HTB)
#define PG8_STAGE(bufoff, gbase, voff) do { _Pragma("unroll") for (int _i = 0; _i < 2; ++_i) { unsigned vo_ = (voff)[_i]; if constexpr (F8) asm volatile("" : "+v"(vo_));     \
        __builtin_amdgcn_global_load_lds((const unsigned*)((const char*)(gbase) + vo_), (PG8_LAS unsigned*)(lds + (bufoff) + ldsw + _i * 8192), 16, 0, 0); } } while (0)
#define PG8_LDA(dst, b, h) do { if constexpr (F8) { _Pragma("unroll") for (int m = 0; m < 4; ++m) dst##8[m] = __builtin_shufflevector(*(const PG8_LAS i32x4*)(lds + PG8_SA(b, h) + aoff + m * 2048), *(const PG8_LAS i32x4*)(lds + PG8_SA(b, h) + aoff + m * 2048 + 1024), 0, 1, 2, 3, 4, 5, 6, 7); } \
        else { _Pragma("unroll") for (int m = 0; m < 4; ++m) _Pragma("unroll") for (int k = 0; k < 2; ++k) dst[m][k] = *(const PG8_LAS bf16x8*)(lds + PG8_SA(b, h) + aoff + m * 2048 + k * 1024); } } while (0)
#define PG8_LDB(dst, b, h) do { if constexpr (F8) { _Pragma("unroll") for (int n = 0; n < 2; ++n) dst##8[n] = __builtin_shufflevector(*(const PG8_LAS i32x4*)(lds + PG8_SB(b, h) + boff + n * 2048), *(const PG8_LAS i32x4*)(lds + PG8_SB(b, h) + boff + n * 2048 + 1024), 0, 1, 2, 3, 4, 5, 6, 7); } \
        else { _Pragma("unroll") for (int n = 0; n < 2; ++n) _Pragma("unroll") for (int k = 0; k < 2; ++k) dst[n][k] = *(const PG8_LAS bf16x8*)(lds + PG8_SB(b, h) + boff + n * 2048 + k * 1024); } } while (0)
#define PG8_MMA(ai, bj, At, Bt) do { __builtin_amdgcn_s_setprio(1); \
        if constexpr (F8) { _Pragma("unroll") for (int m = 0; m < 4; ++m) _Pragma("unroll") for (int n = 0; n < 2; ++n) { \
            acc[ai][bj][m][n] = __builtin_amdgcn_mfma_scale_f32_16x16x128_f8f6f4(Bt##8[n], At##8[m], acc[ai][bj][m][n], 0, 0, 0, 0, 0, 0); } } \
        else { _Pragma("unroll") for (int m = 0; m < 4; ++m) _Pragma("unroll") for (int n = 0; n < 2; ++n) _Pragma("unroll") for (int k = 0; k < 2; ++k) \
            acc[ai][bj][m][n] = __builtin_amdgcn_mfma_f32_16x16x32_bf16(Bt[n][k], At[m][k], acc[ai][bj][m][n], 0, 0, 0); } \
        __builtin_amdgcn_s_setprio(0); } while (0)
#define PG8_WAIT_V(n) asm volatile("s_waitcnt vmcnt(" #n ")" ::: "memory")
#define PG8_WAIT_L(n) asm volatile("s_waitcnt lgkmcnt(" #n ")" ::: "memory")
#define PG8_BAR __builtin_amdgcn_s_barrier()
#define PG8_SCHED __builtin_amdgcn_sched_barrier(0)
    Unit cur, nxt; int ui = 0;
    if (!S.next(0, cur)) return;
    f32x4 acc[2][2][4][2];
#pragma unroll
    for (int a = 0; a < 2; ++a)
#pragma unroll
        for (int b = 0; b < 2; ++b)
#pragma unroll
            for (int m = 0; m < 4; ++m)
#pragma unroll
                for (int n = 0; n < 2; ++n) acc[a][b][m][n] = (f32x4){0.f, 0.f, 0.f, 0.f};
    bf16x8 At[4][2], B0[2][2], B1[2][2]; i32x8 At8[4], B08[2], B18[2];
    const char* cA = S.a_ptr(cur); const char* cB = S.b_ptr(cur);
    S.a_ready(cur);
    if constexpr (SP2) {
        PG8_STAGE(PG8_SB(0, 0), cB, voffB); PG8_STAGE(PG8_SB(0, 1), cB + hstep, voffB); PG8_STAGE(PG8_SA(0, 0), cA, voffA); PG8_STAGE(PG8_SA(0, 1), cA + hstep, voffA);
        if (wr == 1) PG8_BAR;
        PG8_WAIT_V(2); PG8_BAR;
        PG8_STAGE(PG8_SB(1, 0), cB + kstep, voffB); PG8_STAGE(PG8_SA(1, 0), cA + kstep, voffA); PG8_STAGE(PG8_SB(1, 1), cB + hstep + kstep, voffB);
        PG8_WAIT_V(6); PG8_BAR;
    } else {
        PG8_STAGE(PG8_SB(0, 0), cB, voffB); PG8_STAGE(PG8_SA(0, 0), cA, voffA); PG8_STAGE(PG8_SB(0, 1), cB + hstep, voffB); PG8_STAGE(PG8_SA(0, 1), cA + hstep, voffA);
        if (wr == 1) PG8_BAR;
        PG8_WAIT_V(4); PG8_BAR;
        PG8_STAGE(PG8_SB(1, 0), cB + kstep, voffB); PG8_STAGE(PG8_SA(1, 0), cA + kstep, voffA); PG8_STAGE(PG8_SB(1, 1), cB + hstep + kstep, voffB);
        PG8_WAIT_V(6); PG8_BAR;
    }
    for (;;) {
        const bool has_next = S.next(ui + 1, nxt);
        const char* nA = has_next ? S.a_ptr(nxt) : cA; const char* nB = has_next ? S.b_ptr(nxt) : cB;
#pragma unroll 1
        for (int t = 0; t < nt; t += 2) {
            const bool last = (t == nt - 2);
            const char* a1 = cA + (size_t)(t + 1) * kstep;
            const char* a2 = last ? nA : cA + (size_t)(t + 2) * kstep; const char* b2 = last ? nB : cB + (size_t)(t + 2) * kstep;
            const char* a3 = a2 + kstep; const char* b3 = b2 + kstep;
            if (last && has_next) S.a_ready(nxt);
            if constexpr (SP2) {
            PG8_LDB(B0, 0, 0); PG8_LDB(B1, 0, 1); PG8_SCHED; PG8_LDA(At, 0, 0); PG8_STAGE(PG8_SA(1, 1), a1 + hstep, voffA);
            PG8_WAIT_V(8); PG8_WAIT_L(0); PG8_BAR; PG8_MMA(0, 0, At, B0); PG8_MMA(0, 1, At, B1); PG8_BAR; PG8_SCHED;
            PG8_LDA(At, 0, 1); PG8_STAGE(PG8_SB(0, 0), b2, voffB); PG8_STAGE(PG8_SB(0, 1), b2 + hstep, voffB); PG8_STAGE(PG8_SA(0, 0), a2, voffA);
            PG8_WAIT_V(8); PG8_WAIT_L(0); PG8_BAR; PG8_MMA(1, 0, At, B0); PG8_MMA(1, 1, At, B1); PG8_BAR; PG8_SCHED;
            PG8_LDB(B0, 1, 0); PG8_LDB(B1, 1, 1); PG8_SCHED; PG8_LDA(At, 1, 0); PG8_STAGE(PG8_SA(0, 1), a2 + hstep, voffA);
            PG8_WAIT_V(8); PG8_WAIT_L(0); PG8_BAR; PG8_MMA(0, 0, At, B0); PG8_MMA(0, 1, At, B1); PG8_BAR; PG8_SCHED;
            PG8_LDA(At, 1, 1); PG8_STAGE(PG8_SB(1, 0), b3, voffB); PG8_STAGE(PG8_SB(1, 1), b3 + hstep, voffB); PG8_STAGE(PG8_SA(1, 0), a3, voffA);
            PG8_WAIT_V(8); PG8_WAIT_L(0); PG8_BAR; PG8_MMA(1, 0, At, B0); PG8_MMA(1, 1, At, B1); PG8_BAR; PG8_SCHED;
            } else {
            PG8_LDB(B0, 0, 0); PG8_SCHED; PG8_LDA(At, 0, 0); PG8_STAGE(PG8_SA(1, 1), a1 + hstep, voffA);
            PG8_WAIT_L(8); PG8_BAR; PG8_WAIT_L(0); PG8_MMA(0, 0, At, B0); PG8_BAR; PG8_SCHED;
            PG8_LDB(B1, 0, 1); PG8_STAGE(PG8_SB(0, 0), b2, voffB);
            PG8_BAR; PG8_WAIT_L(0); PG8_MMA(0, 1, At, B1); PG8_BAR;
            PG8_LDA(At, 0, 1); PG8_STAGE(PG8_SA(0, 0), a2, voffA);
            PG8_BAR; PG8_WAIT_L(0); PG8_MMA(1, 0, At, B0); PG8_BAR; PG8_SCHED;
            PG8_STAGE(PG8_SB(0, 1), b2 + hstep, voffB);
            PG8_WAIT_V(6); PG8_BAR; PG8_MMA(1, 1, At, B1); PG8_BAR;
            PG8_LDB(B0, 1, 0); PG8_SCHED; PG8_LDA(At, 1, 0); PG8_STAGE(PG8_SA(0, 1), a2 + hstep, voffA);
            PG8_WAIT_L(8); PG8_BAR; PG8_WAIT_L(0); PG8_MMA(0, 0, At, B0); PG8_BAR; PG8_SCHED;
            PG8_LDB(B1, 1, 1); PG8_STAGE(PG8_SB(1, 0), b3, voffB);
            PG8_BAR; PG8_WAIT_L(0); PG8_MMA(0, 1, At, B1); PG8_BAR;
            PG8_LDA(At, 1, 1); PG8_STAGE(PG8_SA(1, 0), a3, voffA);
            PG8_BAR; PG8_WAIT_L(0); PG8_MMA(1, 0, At, B0); PG8_BAR; PG8_SCHED;
            PG8_STAGE(PG8_SB(1, 1), b3 + hstep, voffB);
            PG8_WAIT_V(6); PG8_BAR; PG8_MMA(1, 1, At, B1); PG8_BAR;
            }
        }
        if constexpr (ALIGN_EPI) { if (wr == 0) PG8_BAR; }
        if constexpr (!Epi::AFTER_DRAIN) { E(acc, cur, wr, wc, fr, fq); S.done(cur); }
        if (!has_next) break;
#pragma unroll
        for (int a = 0; a < 2; ++a)
#pragma unroll
            for (int b = 0; b < 2; ++b)
#pragma unroll
                for (int m = 0; m < 4; ++m)
#pragma unroll
                    for (int n = 0; n < 2; ++n) acc[a][b][m][n] = (f32x4){0.f, 0.f, 0.f, 0.f};
        cur = nxt; cA = nA; cB = nB; ++ui;
        if constexpr (ALIGN_EPI) { if (wr == 1) PG8_BAR; }
    }
    PG8_WAIT_V(0);
    if constexpr (!ALIGN_EPI) { if (wr == 0) PG8_BAR; }
    PG8_BAR;
    if constexpr (Epi::AFTER_DRAIN) { E.fused(acc, cur, wr, wc, fr, fq, lds, wid, lane); S.done(cur); }
#undef PG8_SA
#undef PG8_SB
#undef PG8_STAGE
#undef PG8_LDA
#undef PG8_LDB
#undef PG8_MMA
#undef PG8_WAIT_V
#undef PG8_WAIT_L
#undef PG8_BAR
#undef PG8_SCHED
}
}

#define GAS __attribute__((address_space(1)))
#define LAS __attribute__((address_space(3)))
typedef unsigned short bf16;
typedef unsigned v4u __attribute__((ext_vector_type(4)));
typedef float f32x4 __attribute__((ext_vector_type(4)));
typedef short bf16x8 __attribute__((ext_vector_type(8)));
typedef GAS unsigned gu32;
typedef GAS unsigned long long gu64;
#define RLX_AGENT __ATOMIC_RELAXED, __HIP_MEMORY_SCOPE_AGENT
#define LDS_WAIT() asm volatile("s_waitcnt lgkmcnt(0)" ::: "memory")
#define VM_WAIT() asm volatile("s_waitcnt vmcnt(0)" ::: "memory")
__device__ __forceinline__ unsigned long long rt() { return __builtin_amdgcn_s_memrealtime(); }
__device__ __forceinline__ unsigned f2bf(float f) { unsigned u = __builtin_bit_cast(unsigned, f); return (u + 0x7fffu + ((u >> 16) & 1u)) >> 16; }
__device__ __forceinline__ unsigned pk2(float lo, float hi) { return f2bf(lo) | (f2bf(hi) << 16); }

#define XB_TMO      128
#define XB_XCNT(j)  (256  + 64 * (j))
#define XB_XSUB(j)  (1280 + 64 * (j))
#define XB_XGEN(j)  (2304 + 64 * (j))
#define XB_TOP      3328
#define XB_TOPGEN   3392
#define XCD_BAR_WORDS 3456
#define XB_SPIN_CAP (1u << 18)

__device__ __forceinline__ unsigned xb_ld(unsigned* p)              { return __hip_atomic_load(p, __ATOMIC_RELAXED, __HIP_MEMORY_SCOPE_AGENT); }
__device__ __forceinline__ unsigned xb_add(unsigned* p, unsigned v) { return __hip_atomic_fetch_add(p, v, __ATOMIC_RELAXED, __HIP_MEMORY_SCOPE_AGENT); }
__device__ __forceinline__ unsigned xb_xcc_id() { return (unsigned)__builtin_amdgcn_s_getreg((3 << 11) | 20) & 0xFu; }
#define XB_SPIN(cond, bar) do { unsigned _sp = 0; while (cond) { __builtin_amdgcn_s_sleep(1); \
    if ((++_sp & 255u) == 0u) { if (xb_ld(&(bar)[XB_TMO])) break; if (_sp > XB_SPIN_CAP) { atomicAdd(&(bar)[XB_TMO], 1u); break; } } } } while (0)

struct XcdBarrier {
    unsigned* bar; unsigned x;
    volatile LAS unsigned* st;
};

__device__ __forceinline__ XcdBarrier xcd_barrier_post(unsigned* bar, volatile LAS unsigned* st, const bool tid0) {
    XcdBarrier b; b.bar = bar; b.x = xb_xcc_id(); b.st = st;
    if (tid0) (void)xb_add(&bar[XB_XCNT(b.x)], 1u);
    return b;
}
__device__ __forceinline__ void xcd_barrier_complete(unsigned* bar, unsigned x, unsigned& nloc, unsigned& nx) {
    const unsigned G = gridDim.x * gridDim.y * gridDim.z;
    unsigned sum, cnt, mine, sp = 0u;
    for (;;) {
        sum = 0u; cnt = 0u; mine = 0u;
#pragma unroll
        for (unsigned j = 0; j < 16; ++j) { const unsigned c = xb_ld(&bar[XB_XCNT(j)]); sum += c; cnt += (c > 0u) ? 1u : 0u; mine = (j == x) ? c : mine; }
        if (sum == G) break;
        __builtin_amdgcn_s_sleep(1);
        if ((++sp & 255u) == 0u) { if (xb_ld(&bar[XB_TMO])) break; if (sp > XB_SPIN_CAP) { atomicAdd(&bar[XB_TMO], 1u); break; } }
    }
    nloc = mine > 0u ? mine : 1u; nx = cnt > 0u ? cnt : 1u;
}

__device__ __forceinline__ void xcd_barrier(const XcdBarrier& b, const int wave_id) {
    const bool tid0 = wave_id == 0 && lane_id() == 0;
    asm volatile("s_waitcnt vmcnt(0)" ::: "memory");
    __syncthreads();
    if (tid0) {
        unsigned* bar = b.bar;
        __builtin_amdgcn_s_waitcnt(0);
        unsigned nloc = b.st[0], nx = b.st[1];
        if (nloc == 0u) { xcd_barrier_complete(bar, b.x, nloc, nx); b.st[0] = nloc; b.st[1] = nx; }
        const unsigned old = xb_add(&bar[XB_XSUB(b.x)], 1u);
        const unsigned gen = old / nloc;
        if (old + 1u == (gen + 1u) * nloc) {
            __builtin_amdgcn_fence(__ATOMIC_RELEASE, "agent");
            asm volatile("s_waitcnt vmcnt(0)" ::: "memory");
            const unsigned og = xb_add(&bar[XB_TOP], 1u);
            const unsigned tg = og / nx;
            if (og + 1u == (tg + 1u) * nx) xb_add(&bar[XB_TOPGEN], 1u);
            else XB_SPIN(xb_ld(&bar[XB_TOPGEN]) == tg, bar);
            __builtin_amdgcn_fence(__ATOMIC_ACQUIRE, "agent");
            xb_add(&bar[XB_XGEN(b.x)], 1u);
            asm volatile("s_waitcnt vmcnt(0)" ::: "memory");
        } else {
            XB_SPIN(xb_ld(&bar[XB_XGEN(b.x)]) == gen, bar);
            __builtin_amdgcn_fence(__ATOMIC_ACQUIRE, "agent");
            asm volatile("s_waitcnt vmcnt(0)" ::: "memory");
        }
    }
    __syncthreads();
}


namespace att {
constexpr int D = 128, PITCH = 2048;
constexpr float SCALE = 0.08838834764831845f;
constexpr float THR = 8.f;
constexpr int NW = 8, QBLK = 32, KVBLK = 64, QB = NW * QBLK;
constexpr int SHM_V = KVBLK * D * 2, SHM_K = KVBLK * D * 2;
constexpr int LDS_BYTES = 2 * SHM_V + 2 * SHM_K + NW * 64 * 4;
constexpr float OSC = 128.f;
constexpr int WBIG = 0x40000000;
typedef unsigned short u16;
typedef short bf16x8 __attribute__((ext_vector_type(8)));
typedef short s16x4 __attribute__((ext_vector_type(4)));
typedef float f32x16 __attribute__((ext_vector_type(16)));
typedef float f32x4 __attribute__((ext_vector_type(4)));
typedef unsigned u32x4 __attribute__((ext_vector_type(4)));

#define KSWZ(row, colB) ((row) * 256 + ((colB) ^ (((row) & 7) << 4)))
#define SBAR() __builtin_amdgcn_sched_barrier(0)
__device__ __forceinline__ int v_st(int k, int c) { const int kk = (k & ~0xC) | ((k & 4) << 1) | ((k & 8) >> 1); return ((kk >> 3) * 4 + (c >> 5)) * 512 + ((kk & 7) * 32 + (c & 31)) * 2; }
__device__ __forceinline__ int v_rd_base(int lane) { return ((lane & 3) << 3) | (((lane >> 2) & 3) << 6) | (((lane >> 4) & 1) << 5) | (((lane >> 5) & 1) << 8); }
constexpr int v_rd_off(int d0, int ks, int half) { return d0 * 512 + ks * 4096 + half * 2048; }
__device__ __forceinline__ int crow(int r, int hi) { return (r & 3) + 8 * (r >> 2) + 4 * hi; }
__device__ __forceinline__ unsigned cvtpk(float lo, float hi) { unsigned r; asm volatile("v_cvt_pk_bf16_f32 %0, %1, %2" : "=v"(r) : "v"(lo), "v"(hi)); return r; }
__device__ __forceinline__ bf16x8 load8(const u16* p) { return *reinterpret_cast<const bf16x8*>(p); }
__device__ __forceinline__ void mask_tile(f32x16& p0, f32x16& p1, int dq, unsigned W) {
    const float NEG = -__builtin_inff();
#pragma unroll
    for (int r = 0; r < 16; ++r) {
        const int c = (r & 3) + 8 * (r >> 2);
        if ((unsigned)(dq - c) >= W) p0[r] = NEG;
        if ((unsigned)(dq - c - 32) >= W) p1[r] = NEG;
    }
}
__device__ __forceinline__ void partialSM(f32x16& p0, f32x16& p1, float& m_reg, float& mn, float& alpha, const bool ok) {
    float pmax = p0[0]; for (int r = 1; r < 16; ++r) pmax = fmaxf(pmax, p0[r]); for (int r = 0; r < 16; ++r) pmax = fmaxf(pmax, p1[r]);
    { auto rr = __builtin_amdgcn_permlane32_swap(__float_as_uint(pmax), __float_as_uint(pmax), false, false);
      pmax = fmaxf(__uint_as_float(rr[0]), __uint_as_float(rr[1])); }
    pmax = ok ? pmax : -__builtin_inff();
    constexpr float C2 = 1.4426950408889634f * SCALE;
    if (__builtin_expect(__all((pmax - m_reg) * SCALE <= THR), 1)) { mn = m_reg; alpha = 1.f; }
    else { mn = fmaxf(m_reg, pmax); alpha = __builtin_amdgcn_exp2f((m_reg - mn) * C2); m_reg = mn; }
    const float mnL = ok ? -mn * C2 : -__builtin_inff();
    for (int r = 0; r < 16; ++r) p0[r] = fmaf(p0[r], C2, mnL); for (int r = 0; r < 16; ++r) p1[r] = fmaf(p1[r], C2, mnL);
    for (int r = 0; r < 16; ++r) p0[r] = __builtin_amdgcn_exp2f(p0[r]);
}
__device__ __forceinline__ void finishSM(f32x16& p0, f32x16& p1, float alpha, float& l_reg, bf16x8& pa0, bf16x8& pa1, bf16x8& pa2, bf16x8& pa3) {
    for (int r = 0; r < 16; ++r) p1[r] = __builtin_amdgcn_exp2f(p1[r]);
    float ps = 0; for (int r = 0; r < 16; ++r) ps += p0[r]; for (int r = 0; r < 16; ++r) ps += p1[r];
    { auto rr = __builtin_amdgcn_permlane32_swap(__float_as_uint(ps), __float_as_uint(ps), false, false);
      ps = __uint_as_float(rr[0]) + __uint_as_float(rr[1]); }
    l_reg = l_reg * alpha + ps;
#define PK4(P, B_, OUT) do { unsigned a0 = cvtpk(P[B_+0], P[B_+1]), a1 = cvtpk(P[B_+2], P[B_+3]);                          \
        unsigned b0 = cvtpk(P[B_+4], P[B_+5]), b1 = cvtpk(P[B_+6], P[B_+7]);                                             \
        auto r0 = __builtin_amdgcn_permlane32_swap(a0, b0, false, false); auto r1 = __builtin_amdgcn_permlane32_swap(a1, b1, false, false); \
        u32x4 w = {r0[0], r1[0], r0[1], r1[1]}; OUT = *reinterpret_cast<bf16x8*>(&w); } while (0)
    PK4(p0, 0, pa0); PK4(p0, 8, pa1); PK4(p1, 0, pa2); PK4(p1, 8, pa3);
#undef PK4
}
template <int KB>
__device__ __forceinline__ void qkt(f32x16& p0, f32x16& p1, const char* K_lds, int r32, int hi, const bf16x8* qr) {
    p0 = f32x16{}; p1 = f32x16{};
    const char* kb[4];
#pragma unroll
    for (int dd = 0; dd < 4; ++dd) kb[dd] = K_lds + KB * SHM_K + KSWZ(r32, (dd * 16 + hi * 8) * 2);
#pragma unroll
    for (int d0 = 0; d0 < 8; ++d0) { const char* a = kb[d0 & 3] + (d0 >> 2) * 128;
        bf16x8 b0 = *reinterpret_cast<const bf16x8*>(a);
        bf16x8 b1 = *reinterpret_cast<const bf16x8*>(a + 32 * 256);
        p0 = __builtin_amdgcn_mfma_f32_32x32x16_bf16(b0, qr[d0], p0, 0, 0, 0);
        p1 = __builtin_amdgcn_mfma_f32_32x32x16_bf16(b1, qr[d0], p1, 0, 0, 0); }
}
template <int VB>
__device__ __forceinline__ void pv_tile(f32x16* o, int vb0, bf16x8 pa0, bf16x8 pa1, bf16x8 pa2, bf16x8 pa3) {
#define TRRD(dst, off) asm volatile("ds_read_b64_tr_b16 %0, %1 offset:%2" : "=&v"(dst) : "v"(vb0), "i"(off) : "memory")
#define PV_D0(d0) do { s16x4 l0, l1, l2, l3, h0, h1, h2, h3; constexpr int b_ = VB * SHM_V + v_rd_off(d0, 0, 0);     \
        TRRD(l0, b_); TRRD(h0, b_ + 2048); TRRD(l1, b_ + 4096); TRRD(h1, b_ + 6144); TRRD(l2, b_ + 8192); TRRD(h2, b_ + 10240); TRRD(l3, b_ + 12288); TRRD(h3, b_ + 14336); \
        asm volatile("s_waitcnt lgkmcnt(0)" ::: "memory"); SBAR();                 \
        o[d0] = __builtin_amdgcn_mfma_f32_32x32x16_bf16(pa0, (bf16x8){l0[0], l0[1], l0[2], l0[3], h0[0], h0[1], h0[2], h0[3]}, o[d0], 0, 0, 0);   \
        o[d0] = __builtin_amdgcn_mfma_f32_32x32x16_bf16(pa1, (bf16x8){l1[0], l1[1], l1[2], l1[3], h1[0], h1[1], h1[2], h1[3]}, o[d0], 0, 0, 0);   \
        o[d0] = __builtin_amdgcn_mfma_f32_32x32x16_bf16(pa2, (bf16x8){l2[0], l2[1], l2[2], l2[3], h2[0], h2[1], h2[2], h2[3]}, o[d0], 0, 0, 0);   \
        o[d0] = __builtin_amdgcn_mfma_f32_32x32x16_bf16(pa3, (bf16x8){l3[0], l3[1], l3[2], l3[3], h3[0], h3[1], h3[2], h3[3]}, o[d0], 0, 0, 0); } while (0)
    PV_D0(0); PV_D0(1); PV_D0(2); PV_D0(3);
#undef PV_D0
#undef TRRD
}
struct BlockRef { const u16* Q; const u16* K; const u16* V; unsigned char* O; const float* KM; int P0; };
struct Seam { bf16x8 qr[8]; bf16x8 st_v0, st_v1, st_k0, st_k1; };
#define ROW(p, k0, rr) ((p) + (size_t)((k0) + (rr)) * PITCH + sc)
#define VMW() asm volatile("s_waitcnt vmcnt(0)" ::: "memory")
#define VMWN(n) asm volatile("s_waitcnt vmcnt(%0)" :: "i"(n) : "memory")
#define SLOAD_H(Kp, Vp, k0) do { S.st_v0 = load8(ROW(Vp, k0, sr)); S.st_v1 = load8(ROW(Vp, k0, 32 + sr));              \
                         S.st_k0 = load8(ROW(Kp, k0, sr)); S.st_k1 = load8(ROW(Kp, k0, 32 + sr)); } while (0)
#define SWRITE_HK(bf) do { *(bf16x8*)(K_lds + (bf) * SHM_K + kws) = S.st_k0; *(bf16x8*)(K_lds + (bf) * SHM_K + kws + 32 * 256) = S.st_k1; } while (0)
#define SWRITE_HV(bf) do { *(bf16x8*)(V_lds + (bf) * SHM_V + vst0) = S.st_v0; *(bf16x8*)(V_lds + (bf) * SHM_V + vst1) = S.st_v1; } while (0)
#define SWRITE_H(bf) do { SWRITE_HV(bf); SWRITE_HK(bf); } while (0)
__device__ __forceinline__ void moba_prime(const BlockRef& cur, char* lds, Seam& S, const int wid, const int lane) {
    const int tid = wid * 64 + lane, r32 = lane & 31, hi = lane >> 5;
    const int sr = tid >> 4, sc = (tid & 15) * 8, kws = KSWZ(sr, sc * 2); char* K_lds = lds + 2 * SHM_V;
    for (int d0 = 0; d0 < 8; ++d0) S.qr[d0] = load8(cur.Q + (size_t)(wid * QBLK + r32) * PITCH + d0 * 16 + hi * 8);
    SLOAD_H(cur.K, cur.V, 0); VMW(); SWRITE_HK(0);
    __syncthreads();
}
__device__ __forceinline__ void moba_block(const BlockRef& cur, const BlockRef& nxt, char* lds, Seam& S, const int wid, const int lane) {
    const int tid = wid * 64 + lane, r32 = lane & 31, hi = lane >> 5;
    const int qbi = cur.P0 >> 8;
    const int NT = 4 * (qbi + 1);
    const int W = WBIG;
    const int qlo = cur.P0 + wid * QBLK, qm = qlo + r32 - 4 * hi;
    char* V_lds = lds; char* K_lds = lds + 2 * SHM_V;
    float* ws = (float*)(lds + 2 * SHM_V + 2 * SHM_K) + wid * 64; float* li_l = ws, * al_l = ws + 32;
    float m_reg = -1e30f, l_reg = 0; f32x16 o[4] = {};
    const int sr = tid >> 4, sc = (tid & 15) * 8, vst0 = v_st(sr, sc), vst1 = v_st(32 + sr, sc), kws = KSWZ(sr, sc * 2);
    const int vb0 = (int)(uintptr_t)V_lds + v_rd_base(lane);
    const u16* Kh = cur.K; const u16* Vh = cur.V;
    unsigned sel = 0u;
    if (qbi > 0) {
        f32x16 pg = f32x16{};
        bf16x8 kf[8];
#pragma unroll
        for (int d0 = 0; d0 < 8; ++d0) { const f32x4 a = *(const f32x4*)(cur.KM + (r32 & 15) * D + d0 * 16 + hi * 8), b4 = *(const f32x4*)(cur.KM + (r32 & 15) * D + d0 * 16 + hi * 8 + 4);
            u32x4 w = {cvtpk(a[0], a[1]), cvtpk(a[2], a[3]), cvtpk(b4[0], b4[1]), cvtpk(b4[2], b4[3])}; kf[d0] = *reinterpret_cast<bf16x8*>(&w); }
#pragma unroll
        for (int d0 = 0; d0 < 8; ++d0) pg = __builtin_amdgcn_mfma_f32_32x32x16_bf16(kf[d0], S.qr[d0], pg, 0, 0, 0);
        float g[16];
#pragma unroll
        for (int r = 0; r < 8; ++r) { const float own = pg[r], oth = __shfl_xor(own, 32);
            const int j0 = (r & 3) + 8 * (r >> 2);
            g[j0] = hi ? oth : own; g[j0 + 4] = hi ? own : oth; }
#pragma unroll
        for (int rep = 0; rep < 3; ++rep) { float best = -__builtin_inff(); int bi = -1;
#pragma unroll
            for (int j = 0; j < 16; ++j) if (j < qbi && !((sel >> j) & 1u) && g[j] > best) { best = g[j]; bi = j; }
            if (bi >= 0) sel |= 1u << bi; }
    }
    sel |= 0xffff0000u << 0;
#define RESC(a) do { if (__any((a) < 1.f)) { if (hi == 0) al_l[r32] = (a); asm volatile("s_waitcnt lgkmcnt(0)" ::: "memory");              \
                     for (int d_ = 0; d_ < 4; ++d_) for (int r = 0; r < 16; ++r) o[d_][r] *= al_l[crow(r, hi)]; } } while (0)
#define KBASE(t) ((t) * KVBLK)
#define ROWOK(t) ((((t) >> 2) >= qbi) || ((sel >> ((t) >> 2)) & 1u))
#define MASKT(P0_, P1_, t) do { const int kb_ = KBASE(t); if (kb_ + KVBLK - 1 > qlo) mask_tile(P0_, P1_, qm - kb_, (unsigned)W); } while (0)
    constexpr int NQL = 8;
#define SEAM_K0() do { VMWN(NQL); SWRITE_HK(0); SBAR(); } while (0)
    f32x16 pA0, pA1, pB0, pB1; float mnA, mnB, alA, alB; bf16x8 pa0, pa1, pa2, pa3;
    SWRITE_HV(0); SBAR();
    if (NT > 1) { SLOAD_H(Kh, Vh, KBASE(1)); }
    SBAR(); qkt<0>(pA0, pA1, K_lds, r32, hi, S.qr);
    MASKT(pA0, pA1, 0); partialSM(pA0, pA1, m_reg, mnA, alA, ROWOK(0));
    if (NT > 1) { VMW(); SWRITE_H(1); }
    __syncthreads();
#define HALF_STEP(PX0, PX1, mnX, alX, PY0, PY1, alY, t, KB, VB, SB) do {                                                      \
        SBAR(); qkt<KB>(PX0, PX1, K_lds, r32, hi, S.qr);                                                                      \
        finishSM(PY0, PY1, alY, l_reg, pa0, pa1, pa2, pa3); SBAR();                                                           \
        if ((t) + 1 < NT) { SLOAD_H(Kh, Vh, KBASE((t) + 1)); SBAR(); }                                                        \
        pv_tile<VB>(o, vb0, pa0, pa1, pa2, pa3); MASKT(PX0, PX1, (t)); partialSM(PX0, PX1, m_reg, mnX, alX, ROWOK(t));       \
        __syncthreads();                                                                                                      \
        if ((t) + 1 < NT) { VMW(); SWRITE_H(SB); }                                                                            \
        RESC(alX); __syncthreads(); } while (0)
    for (int t = 1; t + 1 < NT; t += 2) {
        HALF_STEP(pB0, pB1, mnB, alB, pA0, pA1, alA, t, 1, 0, 0);
        HALF_STEP(pA0, pA1, mnA, alA, pB0, pB1, alB, t + 1, 0, 1, 1);
    }
    SBAR(); qkt<1>(pB0, pB1, K_lds, r32, hi, S.qr); SBAR();
    SLOAD_H(nxt.K, nxt.V, 0); SBAR();
#pragma unroll
    for (int d0 = 0; d0 < 8; ++d0) S.qr[d0] = load8(nxt.Q + (size_t)(wid * QBLK + r32) * PITCH + d0 * 16 + hi * 8);
    SBAR();
    finishSM(pA0, pA1, alA, l_reg, pa0, pa1, pa2, pa3); SBAR();
    pv_tile<0>(o, vb0, pa0, pa1, pa2, pa3);
    MASKT(pB0, pB1, NT - 1); partialSM(pB0, pB1, m_reg, mnB, alB, ROWOK(NT - 1)); __syncthreads(); RESC(alB);
    finishSM(pB0, pB1, alB, l_reg, pa0, pa1, pa2, pa3); SBAR(); pv_tile<1>(o, vb0, pa0, pa1, pa2, pa3);
    SBAR(); SEAM_K0();
    if (hi == 0) li_l[r32] = l_reg; asm volatile("s_waitcnt lgkmcnt(0)" ::: "memory");
    float rli[16];
#pragma unroll
    for (int r = 0; r < 16; ++r) rli[r] = __builtin_amdgcn_rcpf(li_l[crow(r, hi)]);
    int le_ = lane; asm volatile("" : "+v"(le_));
    unsigned char* Ow = cur.O + (unsigned)((wid * QBLK + 4 * (le_ >> 5)) * PITCH + (le_ & 31));
#pragma unroll
    for (int r = 0; r < 16; ++r) { const int orow0 = (r & 3) + 8 * (r >> 2);
#pragma unroll
        for (int d0 = 0; d0 < 4; ++d0) { const float v = __builtin_amdgcn_fmed3f(o[d0][r] * rli[r] * OSC, -448.f, 448.f);
            const float vn = __shfl_xor(v, 1);
            const int p2 = __builtin_amdgcn_cvt_pk_fp8_f32(v, vn, 0, false);
            const int p4 = __shfl_xor(p2, 2);
            if ((r32 & 3) == 0) *(unsigned*)(Ow + (size_t)orow0 * PITCH + d0 * 32) = ((unsigned)p2 & 0xffffu) | ((unsigned)p4 << 16); } }
    __syncthreads();
#undef RESC
#undef KBASE
#undef ROWOK
#undef MASKT
#undef SEAM_K0
#undef HALF_STEP
}
#undef ROW
#undef VMW
#undef VMWN
#undef SLOAD_H
#undef SWRITE_HK
#undef SWRITE_HV
#undef SWRITE_H
#undef KSWZ
#undef SBAR
}

constexpr int NWAVES = 8, NTHR = 512;
constexpr int BATCH = 4, SEQ = 4096, T = BATCH * SEQ, D = 2048, NH = 16, HD = 128, DEPTH = 4;
constexpr int NQKV = 3 * D, NHIN = 4 * D, NEXP = 32, DEXP = 512, MBLK = 256, NBLK = SEQ / MBLK;
constexpr float ALPHA = 1.6817928305074290f;
constexpr float LN_EPS = 1e-5f, RMS_EPS = 1e-6f;
constexpr float QSCALE = 0.08838834764831845f;
constexpr float W8_SCALE = 128.f, H8_SCALE = 16.f, O8_SCALE = 128.f, Y8_SCALE = 256.f;
constexpr int MAXTILES = 160;

constexpr size_t MiB = 1u << 20;
constexpr size_t WS_CTL = 0, CTL_ZERO_BYTES = 2 * MiB;
constexpr size_t WS_KS = 1 * MiB;
constexpr size_t WS_WQKV = 2 * MiB;
constexpr size_t WS_WOM = 50 * MiB;
constexpr size_t WS_WHIN = 66 * MiB;
constexpr size_t WS_WOH = 130 * MiB;
constexpr size_t WS_W1 = 146 * MiB;
constexpr size_t WS_W2 = 658 * MiB;
constexpr size_t WS_X = 914 * MiB;
constexpr size_t WS_XB = 1042 * MiB;
constexpr size_t WS_Y = 1106 * MiB;
constexpr size_t WS_OB = 1234 * MiB;
constexpr size_t WS_R1 = 1298 * MiB;
constexpr size_t WS_H = 1618 * MiB;
constexpr size_t WS_KM = 1658 * MiB;
constexpr size_t WS_TI = 1659 * MiB;
constexpr size_t WS_WR = 1660 * MiB;
constexpr size_t WS_XL = 1662 * MiB;
constexpr size_t WS_XB8 = 1726 * MiB;
constexpr size_t WS_END = 1758 * MiB;
constexpr int CW_TMO = 0, CW_CODE = 1, CW_BAR = 4096, CW_CNT = 16384;

constexpr int RING_OFF = 0, RING_BYTES = 131072;
constexpr int LDSCTL_OFF = RING_BYTES, MISC_OFF = LDSCTL_OFF + 320;
constexpr int TAB_OFF = LDSCTL_OFF + 1024;
constexpr int LDS_BYTES = 147456;

struct Frame {
    LAS unsigned char* lds;
    volatile LAS unsigned* MISC;
    gu32* ctl;
    int vcu, G, wave;
    unsigned char* ws;
};

__device__ __forceinline__ float wave_sum(float v) {
#pragma unroll
    for (int o = 1; o < 64; o <<= 1) v += __shfl_xor(v, o);
    return v;
}
__device__ __forceinline__ unsigned pk4_fp8(float a, float b, float c, float d) { int w = __builtin_amdgcn_cvt_pk_fp8_f32(a, b, 0, false); w = __builtin_amdgcn_cvt_pk_fp8_f32(c, d, w, true); return (unsigned)w; }
__device__ __forceinline__ float bf2f(unsigned short b) { return __builtin_bit_cast(float, (unsigned)b << 16); }
__device__ __forceinline__ float bflo(unsigned w) { return __builtin_bit_cast(float, w << 16); }
__device__ __forceinline__ float bfhi(unsigned w) { return __builtin_bit_cast(float, w & 0xffff0000u); }

constexpr int CV_NDEF = 1536;
constexpr int CV_NTILES_ALL = 2 * ((D / 128) * (NQKV / 128)) + 4 * ((D / 128) * (D / 128)) + 2 * ((D / 128) * (NHIN / 128)) + 3 * 128 * ((D / 128) * (DEXP / 128));
__device__ __forceinline__ int cv_skip(int j, int d0, int d1, int d2, int d3) { int t = j; if (t >= d0) t += CV_NDEF; if (t >= d1) t += CV_NDEF; if (t >= d2) t += CV_NDEF; if (t >= d3) t += CV_NDEF; return t; }
template <int MODE>
__device__ __forceinline__ void conv_tiles(Frame& F, const float* const* in, const int j0, const int jstride, const int jend, const int lay, const int tid) {
    {
        LAS float* Ls = (LAS float*)(F.lds + RING_OFF);
        constexpr int TS = 129;
        constexpr int T_A = (D / 128) * (NQKV / 128), T_B = (D / 128) * (D / 128), T_C = (D / 128) * (NHIN / 128), T_E = (D / 128) * (DEXP / 128);
        constexpr int NTILES = 2 * T_A + 2 * T_B + 2 * T_C + 2 * T_B + 3 * 128 * T_E;
        constexpr int DOWN0 = NTILES - 128 * T_E;
#define CV_TILE(j_) (MODE == 1 ? (DOWN0 + lay * 32 * T_E + (j_)) : cv_skip((j_), DOWN0, DOWN0 + 1 * 32 * T_E, DOWN0 + 2 * 32 * T_E, DOWN0 + 3 * 32 * T_E))
        unsigned char* Wqkv = F.ws + WS_WQKV; unsigned char* Wom = F.ws + WS_WOM; bf16* Whin = (bf16*)(F.ws + WS_WHIN); bf16* Woh = (bf16*)(F.ws + WS_WOH);
        unsigned char* W1 = F.ws + WS_W1; unsigned char* W2 = F.ws + WS_W2;
#define P0_DECODE(it_, Wsrc, K_, N_, dst, kind, par, k0_, n0_) do { int r_ = (it_); \
        if (r_ < 2 * T_A) { const int m_ = r_ / T_A; r_ -= m_ * T_A; Wsrc = in[1] + (size_t)m_ * D * NQKV; K_ = D; N_ = NQKV; dst = Wqkv + (size_t)m_ * NQKV * D; kind = 1; par = 0; } \
        else if ((r_ -= 2 * T_A) < 2 * T_B) { const int m_ = r_ / T_B; r_ -= m_ * T_B; Wsrc = in[2] + (size_t)m_ * D * D; K_ = D; N_ = D; dst = Wom + (size_t)m_ * D * D; kind = 1; par = 0; } \
        else if ((r_ -= 2 * T_B) < 2 * T_C) { const int m_ = r_ / T_C; r_ -= m_ * T_C; Wsrc = in[3] + (size_t)m_ * D * NHIN; K_ = D; N_ = NHIN; dst = (unsigned char*)(Whin + (size_t)m_ * NHIN * D); kind = 0; par = 0; } \
        else if ((r_ -= 2 * T_C) < 2 * T_B) { const int m_ = r_ / T_B; r_ -= m_ * T_B; Wsrc = in[6] + (size_t)m_ * D * D; K_ = D; N_ = D; dst = (unsigned char*)(Woh + (size_t)m_ * D * D); kind = 0; par = 0; } \
        else if ((r_ -= 2 * T_B) < 128 * T_E) { const int m_ = r_ / T_E; r_ -= m_ * T_E; Wsrc = in[13] + (size_t)m_ * D * DEXP; K_ = D; N_ = DEXP; dst = W1 + (size_t)m_ * 1024 * D; kind = 2; par = 0; } \
        else if ((r_ -= 128 * T_E) < 128 * T_E) { const int m_ = r_ / T_E; r_ -= m_ * T_E; Wsrc = in[14] + (size_t)m_ * D * DEXP; K_ = D; N_ = DEXP; dst = W1 + (size_t)m_ * 1024 * D; kind = 2; par = 1; } \
        else { r_ -= 128 * T_E; const int m_ = r_ / T_E; r_ -= m_ * T_E; Wsrc = in[15] + (size_t)m_ * DEXP * D; K_ = DEXP; N_ = D; dst = W2 + (size_t)m_ * D * DEXP; kind = 1; par = 0; } \
        { const int nb_ = N_ / 128; k0_ = 128 * (r_ / nb_); n0_ = 128 * (r_ % nb_); } } while (0)
        f32x4 v[8];
        int it = j0;
        if (it < jend) { const float* Wsrc; int K_, N_, kind, par, k0_, n0_; unsigned char* dst; P0_DECODE(CV_TILE(it), Wsrc, K_, N_, dst, kind, par, k0_, n0_); (void)dst; (void)kind; (void)par;
#pragma unroll
            for (int i = 0; i < 8; ++i) { const int idx = tid + 512 * i, kr = idx >> 5, n4 = (idx & 31) * 4; v[i] = *(const GAS f32x4*)(Wsrc + (size_t)(k0_ + kr) * N_ + n0_ + n4); } }
#pragma unroll 1
        for (; it < jend; it += jstride) {
            const float* Wsrc; int K_, N_, kind, par, k0_, n0_; unsigned char* dst; P0_DECODE(CV_TILE(it), Wsrc, K_, N_, dst, kind, par, k0_, n0_); (void)Wsrc;
#pragma unroll
            for (int i = 0; i < 8; ++i) { const int idx = tid + 512 * i, kr = idx >> 5, n4 = (idx & 31) * 4; LAS float* p = Ls + kr * TS + n4; p[0] = v[i].x; p[1] = v[i].y; p[2] = v[i].z; p[3] = v[i].w; }
            LDS_WAIT(); __builtin_amdgcn_s_barrier(); asm volatile("" ::: "memory");
            if (it + jstride < jend) { const float* Wn; int Kn, Nn, kindn, parn, k0n, n0n; unsigned char* dstn; P0_DECODE(CV_TILE(it + jstride), Wn, Kn, Nn, dstn, kindn, parn, k0n, n0n); (void)dstn; (void)kindn; (void)parn; (void)Kn;
#pragma unroll
                for (int i = 0; i < 8; ++i) { const int idx = tid + 512 * i, kr = idx >> 5, n4 = (idx & 31) * 4; v[i] = *(const GAS f32x4*)(Wn + (size_t)(k0n + kr) * Nn + n0n + n4); } }
#pragma unroll
            for (int r = 0; r < 4; ++r) { const int q = tid + 512 * r, c = q & 15, nl = q >> 4;
                const LAS float* sp = Ls + (8 * c) * TS + nl;
                const float f0 = sp[0 * TS], f1 = sp[1 * TS], f2 = sp[2 * TS], f3 = sp[3 * TS], f4 = sp[4 * TS], f5 = sp[5 * TS], f6 = sp[6 * TS], f7 = sp[7 * TS];
                const int sn = n0_ + nl;
                const int drow = kind == 2 ? (256 * (sn >> 7) + 128 * ((sn >> 2) & 1) + 32 * ((sn >> 5) & 3) + 8 * ((sn >> 3) & 3) + 4 * par + (sn & 3)) : sn;
                if (kind == 0) { v4u o; o.x = pk2(f0, f1); o.y = pk2(f2, f3); o.z = pk2(f4, f5); o.w = pk2(f6, f7); *(GAS v4u*)((bf16*)dst + (size_t)drow * K_ + k0_ + 8 * c) = o; }
                else { typedef unsigned u32x2_ __attribute__((ext_vector_type(2)));
                    *(GAS u32x2_*)(dst + (size_t)drow * K_ + k0_ + 8 * c) = (u32x2_){pk4_fp8(f0 * W8_SCALE, f1 * W8_SCALE, f2 * W8_SCALE, f3 * W8_SCALE), pk4_fp8(f4 * W8_SCALE, f5 * W8_SCALE, f6 * W8_SCALE, f7 * W8_SCALE)}; } }
            LDS_WAIT(); __builtin_amdgcn_s_barrier(); asm volatile("" ::: "memory");
        }
#undef P0_DECODE
#undef CV_TILE
    }
}
__device__ __forceinline__ void p0_prologue(Frame& F, const float* const* in) {
    const int wave = F.wave; int lane = lane_id(); asm volatile("" : "+v"(lane)); const int tid = wave * 64 + lane; (void)tid;

    const int gw = F.vcu * NWAVES + wave, NGW = F.G * NWAVES;
    conv_tiles<0>(F, in, F.vcu, F.G, CV_NTILES_ALL - DEPTH * CV_NDEF, 0, tid);
    { bf16* WR = (bf16*)(F.ws + WS_WR);
      for (int idx = F.vcu * NTHR + tid; idx < DEPTH * 48 * D; idx += F.G * NTHR) { const int l = idx / (48 * D), n = (idx / D) % 48, k = idx % D;
          float w = 0.f; if (n < 4) w = in[9][((size_t)l * D + k) * 4 + n]; else if (n < 36) { const int g = (n - 4) >> 3, e = (n - 4) & 7; w = in[11][(((size_t)l * 4 + g) * D + k) * 8 + e]; }
          const unsigned hi = f2bf(w), lo = f2bf(w - bf2f((unsigned short)hi));
          WR[((size_t)l * 2 + 0) * 48 * D + (size_t)n * D + k] = (bf16)hi; WR[((size_t)l * 2 + 1) * 48 * D + (size_t)n * D + k] = (bf16)lo; } }
    const float* x = in[0]; unsigned char* XB8 = F.ws + WS_XB8;
#pragma unroll 1
    for (int m = gw; m < T; m += NGW) {
        const GAS f32x4* xr = (const GAS f32x4*)(x + (size_t)m * D) + lane; GAS unsigned* o4 = (GAS unsigned*)(XB8 + (size_t)m * D) + lane;
#pragma unroll
        for (int j = 0; j < 8; ++j) { const f32x4 v = xr[64 * j]; o4[64 * j] = pk4_fp8(v.x, v.y, v.z, v.w); }
    }
}


__device__ __forceinline__ att::BlockRef attn_ref(Frame& F, int L, int pass, int jj) {
    const int bh = L >> 3, x = L & 7, qb = pass ? (NBLK - 1 - x) : x, b = bh >> 4, h = bh & 15;
    const bf16* QBp = (const bf16*)(F.ws + WS_R1); unsigned char* OBp = F.ws + WS_OB; const float* KMS = (const float*)(F.ws + WS_KS) + (size_t)jj * (BATCH * NH * NBLK * HD);
    att::BlockRef r; const size_t qoff = (size_t)(b * SEQ + qb * MBLK) * D + h * HD, koff = (size_t)(b * SEQ) * D + h * HD;
    r.Q = QBp + qoff; r.K = QBp + (size_t)T * D + koff; r.V = QBp + 2 * (size_t)T * D + koff; r.O = OBp + qoff; r.KM = KMS + (size_t)bh * NBLK * HD; r.P0 = qb * MBLK;
    return r;
}
__device__ __forceinline__ void attn_mfma_phase(Frame& F, int jj) {
    const int wave = F.wave; const int lane = lane_id();
    char* ldsg = (char*)(F.lds + RING_OFF);
    constexpr int NITEM = BATCH * NH * (NBLK / 2);
    int L = F.vcu;
    if (L < NITEM) {
        int pass = 0;
        att::BlockRef cur = attn_ref(F, L, 0, jj);
        att::Seam S;
        att::moba_prime(cur, ldsg, S, wave, lane);
        for (;;) {
            const bool more_pass = pass == 0, more_item = L + F.G < NITEM, last = !more_pass && !more_item;
            int passn = pass + 1, Ln = L;
            if (!more_pass) { passn = 0; Ln = more_item ? L + F.G : L; }
            const att::BlockRef nxt = last ? cur : attn_ref(F, Ln, passn, jj);
            att::moba_block(cur, nxt, ldsg, S, wave, lane);
            if (last) break;
            cur = nxt; pass = passn; L = Ln;
        }
    }
    asm volatile("s_waitcnt vmcnt(0)" ::: "memory");
    __syncthreads();
}


namespace scn {
constexpr int RS_K = 272, RS_S = 144;
constexpr int OFF_QG = 0, OFF_QA = 17408, OFF_KA = 34816, OFF_ST = 52224, OFF_KDT = 60928, OFF_IT = 79360, OFF_AL = 83968, OFF_D = 93184, OFF_SEG = 93696, END = 97792;
typedef short bf16x8 __attribute__((ext_vector_type(8)));
typedef float f32x16 __attribute__((ext_vector_type(16)));
typedef float f32x4 __attribute__((ext_vector_type(4)));
typedef float f32x2 __attribute__((ext_vector_type(2)));
typedef unsigned u32x2 __attribute__((ext_vector_type(2)));
typedef unsigned u32x4 __attribute__((ext_vector_type(4)));
__device__ __forceinline__ unsigned pk(float lo, float hi) { unsigned r; asm volatile("v_cvt_pk_bf16_f32 %0, %1, %2" : "=v"(r) : "v"(lo), "v"(hi)); return r; }
}
__device__ __forceinline__ void scan_mfma_phase(Frame& F) {
    using namespace scn;
#define SCAN_BAR() do { asm volatile("s_waitcnt lgkmcnt(0)" ::: "memory"); __builtin_amdgcn_s_barrier(); asm volatile("" ::: "memory"); } while (0)
    const int wave = F.wave; const int lane = lane_id(); const int tid = wave * 64 + lane;
    const bf16* QH = (const bf16*)(F.ws + WS_R1); const float* LF = (const float*)(F.ws + WS_R1 + 64 * MiB); const bf16* IH = (const bf16*)(F.ws + WS_R1 + 192 * MiB); const bf16* KKH = (const bf16*)(F.ws + WS_OB);
    bf16* OSB = (bf16*)(F.ws + WS_Y);
    LAS unsigned char* L = F.lds + RING_OFF;
    const int l32 = lane & 31, kh = lane >> 5;
    const int k0 = 2 * lane;
    const int is_ = tid >> 3, iv4 = (tid & 7) * 4;
    for (int u = F.vcu; u < BATCH * NH * 4; u += F.G) {
        const int bh = u >> 2, vs = u & 3, b = bh >> 4, h = bh & 15;
        __syncthreads();
        for (int i = tid; i < 8704 / 4; i += NTHR) ((LAS unsigned*)(L + OFF_ST))[i] = 0u;
        f32x16 S = f32x16{};
        const size_t colq = (size_t)h * HD + k0, coli = (size_t)h * HD + vs * 32 + iv4;
        f32x2 lfv[2][8]; unsigned qv[2][8], kv[2][8]; u32x2 ivv[2];
#define SCAN_LOADS(p_, rb_) do { _Pragma("unroll") for (int j = 0; j < 8; ++j) { const size_t g_ = ((rb_) + 8 * wave + j) * D + colq; \
            asm volatile("global_load_dwordx2 %0, %1, off" : "=v"(lfv[p_][j]) : "v"(LF + g_)); asm volatile("global_load_dword %0, %1, off" : "=v"(qv[p_][j]) : "v"(QH + g_)); asm volatile("global_load_dword %0, %1, off" : "=v"(kv[p_][j]) : "v"(KKH + g_)); } \
          asm volatile("global_load_dwordx2 %0, %1, off" : "=v"(ivv[p_]) : "v"(IH + ((rb_) + is_) * D + coli)); } while (0)
        SCAN_LOADS(0, (size_t)(b * SEQ)); SCAN_LOADS(1, (size_t)(b * SEQ + 64));
#pragma unroll 1
        for (int c2 = 0; c2 < SEQ / 64; c2 += 2) {
#pragma unroll
          for (int p = 0; p < 2; ++p) { const int c = c2 + p;
            const size_t row0 = (size_t)(b * SEQ + c * 64);
            if (c < SEQ / 64 - 1) asm volatile("s_waitcnt vmcnt(25)" ::: "memory"); else asm volatile("s_waitcnt vmcnt(0)" ::: "memory");
#pragma unroll
            for (int j = 0; j < 8; ++j) asm volatile("" : "+v"(lfv[p][j]), "+v"(qv[p][j]), "+v"(kv[p][j]));
            asm volatile("" : "+v"(ivv[p]));
            float c0[8], c1[8];
            { float a0 = 0.f, a1 = 0.f;
#pragma unroll
              for (int j = 0; j < 8; ++j) { a0 += lfv[p][j].x; a1 += lfv[p][j].y; c0[j] = a0; c1[j] = a1; }
              *(LAS f32x2*)(L + OFF_SEG + (wave * 128 + k0) * 4) = (f32x2){a0, a1}; }
            SCAN_BAR();
            float off0 = 0.f, off1 = 0.f, gm0 = 0.f, gm1 = 0.f, gl0 = 0.f, gl1 = 0.f;
#pragma unroll
            for (int t8 = 0; t8 < 8; ++t8) { const f32x2 sv = *(const LAS f32x2*)(L + OFF_SEG + (t8 * 128 + k0) * 4);
                if (t8 < wave) { off0 += sv.x; off1 += sv.y; } if (t8 < 4) { gm0 += sv.x; gm1 += sv.y; } gl0 += sv.x; gl1 += sv.y; }
            { float kd0[8], kd1[8];
              const float egm0 = __builtin_amdgcn_exp2f(gm0), egm1 = __builtin_amdgcn_exp2f(gm1), eglm0 = __builtin_amdgcn_exp2f(gl0 - gm0), eglm1 = __builtin_amdgcn_exp2f(gl1 - gm1);
#pragma unroll
              for (int j = 0; j < 8; ++j) { const int t = 8 * wave + j;
                  const float A0 = __builtin_amdgcn_exp2f(fminf(off0 + c0[j] - gm0, 120.f)), A1 = __builtin_amdgcn_exp2f(fminf(off1 + c1[j] - gm1, 120.f));
                  const float r0 = __builtin_amdgcn_rcpf(A0), r1 = __builtin_amdgcn_rcpf(A1);
                  const float q0 = bflo(qv[p][j]) * A0, q1 = bfhi(qv[p][j]) * A1;
                  const float kk0 = bflo(kv[p][j]) * r0, kk1 = bfhi(kv[p][j]) * r1;
                  *(LAS unsigned*)(L + OFF_QG + t * RS_K + k0 * 2) = pk(q0 * egm0, q1 * egm1);
                  *(LAS unsigned*)(L + OFF_QA + t * RS_K + k0 * 2) = pk(q0, q1);
                  *(LAS unsigned*)(L + OFF_KA + t * RS_K + k0 * 2) = pk(kk0, kk1);
                  kd0[j] = kk0 * eglm0; kd1[j] = kk1 * eglm1; }
              u32x4 w0, w1; w0.x = pk(kd0[0], kd0[1]); w0.y = pk(kd0[2], kd0[3]); w0.z = pk(kd0[4], kd0[5]); w0.w = pk(kd0[6], kd0[7]);
              w1.x = pk(kd1[0], kd1[1]); w1.y = pk(kd1[2], kd1[3]); w1.z = pk(kd1[4], kd1[5]); w1.w = pk(kd1[6], kd1[7]);
              *(LAS u32x4*)(L + OFF_KDT + k0 * RS_S + wave * 16) = w0; *(LAS u32x4*)(L + OFF_KDT + (k0 + 1) * RS_S + wave * 16) = w1;
              if (wave == 0) *(LAS f32x2*)(L + OFF_D + k0 * 4) = (f32x2){__builtin_amdgcn_exp2f(gl0), __builtin_amdgcn_exp2f(gl1)}; }
            { const unsigned i0 = ivv[p].x, i1 = ivv[p].y;
              *(LAS unsigned short*)(L + OFF_IT + (iv4 + 0) * RS_S + is_ * 2) = (unsigned short)(i0 & 0xffffu); *(LAS unsigned short*)(L + OFF_IT + (iv4 + 1) * RS_S + is_ * 2) = (unsigned short)(i0 >> 16);
              *(LAS unsigned short*)(L + OFF_IT + (iv4 + 2) * RS_S + is_ * 2) = (unsigned short)(i1 & 0xffffu); *(LAS unsigned short*)(L + OFF_IT + (iv4 + 3) * RS_S + is_ * 2) = (unsigned short)(i1 >> 16); }
            SCAN_BAR();
            if (c + 2 < SEQ / 64) SCAN_LOADS(p, row0 + 128);
            f32x16 acc = f32x16{};
            int tt = 0;
            if (wave < 4) {
                f32x16 ds = f32x16{};
#pragma unroll
                for (int ss = 0; ss < 4; ++ss) { const bf16x8 a = *(const LAS bf16x8*)(L + OFF_KDT + (32 * wave + l32) * RS_S + (16 * ss + 8 * kh) * 2), bq = *(const LAS bf16x8*)(L + OFF_IT + l32 * RS_S + (16 * ss + 8 * kh) * 2);
                    ds = __builtin_amdgcn_mfma_f32_32x32x16_bf16(a, bq, ds, 0, 0, 0); }
#pragma unroll
                for (int q = 0; q < 4; ++q) { const f32x4 dd = *(const LAS f32x4*)(L + OFF_D + (32 * wave + 8 * q + 4 * kh) * 4);
#pragma unroll
                    for (int i = 0; i < 4; ++i) S[4 * q + i] = dd[i] * S[4 * q + i] + ds[4 * q + i]; }
                if (wave < 3) {
                    const int st = wave == 2 ? 1 : 0; tt = wave >= 1 ? 1 : 0;
#pragma unroll
                    for (int ks = 0; ks < 8; ++ks) { const bf16x8 a = *(const LAS bf16x8*)(L + OFF_KA + (32 * st + l32) * RS_K + (16 * ks + 8 * kh) * 2), bq = *(const LAS bf16x8*)(L + OFF_QA + (32 * tt + l32) * RS_K + (16 * ks + 8 * kh) * 2);
                        acc = __builtin_amdgcn_mfma_f32_32x32x16_bf16(a, bq, acc, 0, 0, 0); }
#pragma unroll
                    for (int q = 0; q < 4; ++q) { float v4[4];
#pragma unroll
                        for (int i = 0; i < 4; ++i) { const int sl = 8 * q + 4 * kh + i; v4[i] = (st != tt || sl <= l32) ? acc[4 * q + i] : 0.f; }
                        *(LAS u32x2*)(L + OFF_AL + (32 * tt + l32) * RS_S + (32 * st + 8 * q + 4 * kh) * 2) = (u32x2){pk(v4[0], v4[1]), pk(v4[2], v4[3])}; }
                }
            } else if (wave < 6) {
                tt = wave - 4;
#pragma unroll
                for (int ks = 0; ks < 8; ++ks) { const bf16x8 a = *(const LAS bf16x8*)(L + OFF_QG + (32 * tt + l32) * RS_K + (16 * ks + 8 * kh) * 2), bq = *(const LAS bf16x8*)(L + OFF_ST + l32 * RS_K + (16 * ks + 8 * kh) * 2);
                    acc = __builtin_amdgcn_mfma_f32_32x32x16_bf16(a, bq, acc, 0, 0, 0); }
            }
            SCAN_BAR();
            if (wave < 4) {
#pragma unroll
                for (int q = 0; q < 4; ++q) *(LAS u32x2*)(L + OFF_ST + l32 * RS_K + (32 * wave + 8 * q + 4 * kh) * 2) = (u32x2){pk(S[4 * q + 0], S[4 * q + 1]), pk(S[4 * q + 2], S[4 * q + 3])};
            } else if (wave < 6) {
#pragma unroll
                for (int ss = 0; ss < 4; ++ss) if (ss < 2 || tt == 1) { const bf16x8 a = *(const LAS bf16x8*)(L + OFF_AL + (32 * tt + l32) * RS_S + (16 * ss + 8 * kh) * 2), bq = *(const LAS bf16x8*)(L + OFF_IT + l32 * RS_S + (16 * ss + 8 * kh) * 2);
                    acc = __builtin_amdgcn_mfma_f32_32x32x16_bf16(a, bq, acc, 0, 0, 0); }
                bf16* op = OSB + (row0 + 32 * tt + 4 * kh) * D + (size_t)h * HD + vs * 32 + l32;
#pragma unroll
                for (int r = 0; r < 16; ++r) { const float nb = __shfl_xor(acc[r], 1); if ((l32 & 1) == 0) *(unsigned*)(op + (size_t)((r & 3) + 8 * (r >> 2)) * D) = pk(acc[r], nb); }
            }
            SCAN_BAR();
          }
        }
#undef SCAN_LOADS
    }
    __syncthreads();
}

#undef SCAN_BAR
__device__ __forceinline__ void gatenorm_phase(Frame& F, const float* gnorm) {
    const int wave = F.wave; int lane = lane_id(); asm volatile("" : "+v"(lane)); const int tid = wave * 64 + lane; (void)tid;

    const bf16* OS = (const bf16*)(F.ws + WS_Y); const bf16* GH = (const bf16*)(F.ws + WS_R1 + 256 * MiB); bf16* OB = (bf16*)(F.ws + WS_OB);
    const int gw = F.vcu * NWAVES + wave, NGW = F.G * NWAVES;
    const f32x4 gn = *(const f32x4*)(gnorm + 4 * (lane & 31));
#pragma unroll 1
    for (int m = gw; m < T; m += 2 * NGW) {
        int mr[2]; mr[0] = m; mr[1] = (m + NGW < T) ? m + NGW : m;
        unsigned long long vq[2][8]; unsigned long long gq[2][8];
#pragma unroll
        for (int r = 0; r < 2; ++r) { const GAS unsigned long long* orow = (const GAS unsigned long long*)(OS + (size_t)mr[r] * D) + lane; const GAS unsigned long long* grow = (const GAS unsigned long long*)(GH + (size_t)mr[r] * D) + lane;
#pragma unroll
            for (int j = 0; j < 8; ++j) { vq[r][j] = orow[64 * j]; gq[r][j] = grow[64 * j]; } }
#pragma unroll
        for (int r = 0; r < 2; ++r) { GAS unsigned long long* o8 = (GAS unsigned long long*)(OB + (size_t)mr[r] * D) + lane;
#pragma unroll
            for (int j = 0; j < 8; ++j) { const unsigned x0 = (unsigned)vq[r][j], x1 = (unsigned)(vq[r][j] >> 32); const f32x4 x = (f32x4){bflo(x0), bfhi(x0), bflo(x1), bfhi(x1)};
                float ss = (x.x * x.x + x.y * x.y) + (x.z * x.z + x.w * x.w);
#pragma unroll
                for (int o = 1; o < 32; o <<= 1) ss += __shfl_xor(ss, o);
                const float rs = 1.0f / sqrtf(ss * (1.0f / HD) + RMS_EPS);
                const unsigned g0 = (unsigned)gq[r][j], g1 = (unsigned)(gq[r][j] >> 32);
                o8[64 * j] = (unsigned long long)pk2(x.x * rs * gn.x * bflo(g0), x.y * rs * gn.y * bfhi(g0)) | ((unsigned long long)pk2(x.z * rs * gn.z * bflo(g1), x.w * rs * gn.w * bfhi(g1)) << 32); } }
    }
}

__device__ __forceinline__ void ln_route_phase(Frame& F, int layer, const float* lng, const float* lnb, const float* wrg, const float* brg, const float* wre, const float* bre) {
    const int wave = F.wave; int lane = lane_id(); asm volatile("" : "+v"(lane)); const int tid = wave * 64 + lane; (void)tid;

    const bf16* Y = (const bf16*)(F.ws + WS_Y);
    const int NGW = F.G * NWAVES;
    typedef short bf16x8r __attribute__((ext_vector_type(8)));
    LAS unsigned char* LH = F.lds + RING_OFF; LAS unsigned char* LL = LH + 65536;
    const bf16* WH = (const bf16*)(F.ws + WS_WR) + (size_t)layer * 2 * 48 * D; const bf16* WL = WH + 48 * D;
    const int l16 = lane & 15, kq = lane >> 4;
#define LNR_BAR() do { asm volatile("s_waitcnt lgkmcnt(0)" ::: "memory"); __builtin_amdgcn_s_barrier(); asm volatile("" ::: "memory"); } while (0)
    int it = 0;
#pragma unroll 1
    for (int mb = F.vcu * NWAVES; mb < T; mb += 2 * NGW, ++it) {
        const int m = mb + wave; bool ok[2]; ok[0] = m < T; ok[1] = m + NGW < T;
        int mr[2]; mr[0] = ok[0] ? m : T - 1; mr[1] = ok[1] ? m + NGW : T - 1;
        f32x4 v[2][8]; float s[2];
#pragma unroll
        for (int r = 0; r < 2; ++r) { const GAS unsigned long long* yr = (const GAS unsigned long long*)(Y + (size_t)mr[r] * D) + lane; s[r] = 0.f;
#pragma unroll
            for (int j = 0; j < 8; ++j) { const unsigned long long yq = yr[64 * j]; const unsigned y0 = (unsigned)yq, y1 = (unsigned)(yq >> 32); v[r][j] = (f32x4){bflo(y0), bfhi(y0), bflo(y1), bfhi(y1)}; } }
#pragma unroll
        for (int r = 0; r < 2; ++r) {
#pragma unroll
            for (int j = 0; j < 8; ++j) s[r] += (v[r][j].x + v[r][j].y) + (v[r][j].z + v[r][j].w); }
        float mean[2], s2[2], rstd[2];
#pragma unroll
        for (int r = 0; r < 2; ++r) { mean[r] = wave_sum(s[r]) * (1.0f / D); s2[r] = 0.f;
#pragma unroll
            for (int j = 0; j < 8; ++j) { v[r][j] = v[r][j] - mean[r]; s2[r] += (v[r][j].x * v[r][j].x + v[r][j].y * v[r][j].y) + (v[r][j].z * v[r][j].z + v[r][j].w * v[r][j].w); } }
#pragma unroll
        for (int r = 0; r < 2; ++r) rstd[r] = 1.0f / sqrtf(wave_sum(s2[r]) * (1.0f / D) + LN_EPS);
#pragma unroll
        for (int j = 0; j < 8; ++j) { const f32x4 g4 = ((const f32x4*)lng)[lane + 64 * j], b4 = ((const f32x4*)lnb)[lane + 64 * j];
#pragma unroll
            for (int r = 0; r < 2; ++r) { v[r][j] = v[r][j] * rstd[r] * g4 + b4;
                if (ok[r]) ((GAS unsigned*)(F.ws + WS_XB8 + (size_t)mr[r] * D) + lane)[64 * j] = pk4_fp8(v[r][j].x, v[r][j].y, v[r][j].z, v[r][j].w);
                {
                    const unsigned h0 = pk2(v[r][j].x, v[r][j].y), h1 = pk2(v[r][j].z, v[r][j].w);
                    const unsigned l0 = pk2(v[r][j].x - bflo(h0), v[r][j].y - bfhi(h0)), l1 = pk2(v[r][j].z - bflo(h1), v[r][j].w - bfhi(h1));
                    const int rho = r * 8 + wave, ch = (lane >> 1) + 32 * j, addr = rho * 4096 + ((ch ^ rho) << 4) + (lane & 1) * 8;
                    *(LAS unsigned long long*)(LH + addr) = (unsigned long long)h0 | ((unsigned long long)h1 << 32);
                    *(LAS unsigned long long*)(LL + addr) = (unsigned long long)l0 | ((unsigned long long)l1 << 32); } } }
        LNR_BAR();
        f32x4 acc[3];
#pragma unroll
        for (int ct = 0; ct < 3; ++ct) acc[ct] = (f32x4){0.f, 0.f, 0.f, 0.f};
#pragma unroll 4
        for (int ks = 0; ks < 8; ++ks) {
            const int ch = 32 * wave + 4 * ks + kq, aaddr = l16 * 4096 + ((ch ^ l16) << 4), kb = 256 * wave + 32 * ks + 8 * kq;
            const bf16x8r ah = *(const LAS bf16x8r*)(LH + aaddr), al = *(const LAS bf16x8r*)(LL + aaddr);
            bf16x8r bh[3], bl[3];
#pragma unroll
            for (int ct = 0; ct < 3; ++ct) { bh[ct] = *(const GAS bf16x8r*)(WH + (size_t)(ct * 16 + l16) * D + kb); bl[ct] = *(const GAS bf16x8r*)(WL + (size_t)(ct * 16 + l16) * D + kb); }
#pragma unroll
            for (int ct = 0; ct < 3; ++ct) {
                acc[ct] = __builtin_amdgcn_mfma_f32_16x16x32_bf16(ah, bh[ct], acc[ct], 0, 0, 0);
                acc[ct] = __builtin_amdgcn_mfma_f32_16x16x32_bf16(al, bh[ct], acc[ct], 0, 0, 0);
                acc[ct] = __builtin_amdgcn_mfma_f32_16x16x32_bf16(ah, bl[ct], acc[ct], 0, 0, 0); }
        }
        LNR_BAR();
        LAS float* P = (LAS float*)LH;
#pragma unroll
        for (int ct = 0; ct < 3; ++ct)
#pragma unroll
            for (int r = 0; r < 4; ++r) P[(wave * 16 + 4 * kq + r) * 48 + ct * 16 + l16] = acc[ct][r];
        LNR_BAR();
        if (wave == 0) {
            volatile LAS unsigned* lc = (volatile LAS unsigned*)(LH + 32768);
            if (lane < 32) lc[lane] = 0u;
            asm volatile("s_waitcnt lgkmcnt(0)" ::: "memory");
            int ex1 = 0, ex2 = 0; float w1 = 0.f, w2 = 0.f; unsigned k1 = 0u, k2 = 0u;
            const int mrow = (F.vcu * NWAVES + (lane & 7)) + (2 * it + ((lane >> 3) & 1)) * NGW;
            const bool rowok = lane < 16 && mrow < T;
            if (rowok) {
                const int rho = lane;
                float g4[4];
#pragma unroll
                for (int n = 0; n < 4; ++n) { float a = 0.f;
#pragma unroll
                    for (int q = 0; q < 8; ++q) a += P[(q * 16 + rho) * 48 + n];
                    g4[n] = a + brg[n]; }
                const float gmx = fmaxf(fmaxf(g4[0], g4[1]), fmaxf(g4[2], g4[3]));
                const float e0 = __expf(g4[0] - gmx), e1 = __expf(g4[1] - gmx), e2 = __expf(g4[2] - gmx), e3 = __expf(g4[3] - gmx);
                const float gs = (e0 + e1) + (e2 + e3);
                const float p0 = e0 / gs, p1 = e1 / gs, p2 = e2 / gs, p3 = e3 / gs;
                int gi = 0; float gwt = p0; if (p1 > gwt) { gwt = p1; gi = 1; } if (p2 > gwt) { gwt = p2; gi = 2; } if (p3 > gwt) { gwt = p3; gi = 3; }
                float c[8]; float cmx = -__builtin_inff();
#pragma unroll
                for (int n = 0; n < 8; ++n) { const int col = 4 + gi * 8 + n; float a = 0.f;
#pragma unroll
                    for (int q = 0; q < 8; ++q) a += P[(q * 16 + rho) * 48 + col];
                    c[n] = a + bre[gi * 8 + n]; cmx = fmaxf(cmx, c[n]); }
                float es = 0.f;
#pragma unroll
                for (int n = 0; n < 8; ++n) { c[n] = __expf(c[n] - cmx); es += c[n]; }
                int i1 = 0; float q1 = -1.f;
#pragma unroll
                for (int n = 0; n < 8; ++n) { c[n] = c[n] / es; if (c[n] > q1) { q1 = c[n]; i1 = n; } }
                int i2 = 0; float q2 = -1.f;
#pragma unroll
                for (int n = 0; n < 8; ++n) if (n != i1 && c[n] > q2) { q2 = c[n]; i2 = n; }
                const float qs = q1 + q2; w1 = gwt * (q1 / qs); w2 = gwt * (q2 / qs);
                ex1 = gi * 8 + i1; ex2 = gi * 8 + i2;
                k1 = __hip_atomic_fetch_add((LAS unsigned*)(lc + ex1), 1u, __ATOMIC_RELAXED, __HIP_MEMORY_SCOPE_WORKGROUP);
                k2 = __hip_atomic_fetch_add((LAS unsigned*)(lc + ex2), 1u, __ATOMIC_RELAXED, __HIP_MEMORY_SCOPE_WORKGROUP);
            }
            asm volatile("s_waitcnt lgkmcnt(0)" ::: "memory");
            if (lane < 32) { const unsigned n_e = lc[lane]; unsigned b_e = 0u; if (n_e) b_e = __hip_atomic_fetch_add(F.ctl + CW_CNT + (layer * 32 + lane) * 32, n_e, RLX_AGENT); lc[32 + lane] = b_e; }
            asm volatile("s_waitcnt vmcnt(0) lgkmcnt(0)" ::: "memory");
            if (rowok) {
                unsigned* TI = (unsigned*)(F.ws + WS_TI);
                const unsigned s1 = lc[32 + ex1] + k1, sl2 = lc[32 + ex2] + k2;
                v4u t0; t0.x = (unsigned)ex1; t0.y = s1; t0.z = __float_as_uint(w1); t0.w = 0u;
                v4u t1; t1.x = (unsigned)ex2; t1.y = sl2; t1.z = __float_as_uint(w2); t1.w = 0u;
                *(GAS v4u*)(TI + (size_t)mrow * 8) = t0; *(GAS v4u*)(TI + (size_t)mrow * 8 + 4) = t1;
            }
        }
        LNR_BAR();
    }
#undef LNR_BAR
}
__device__ __forceinline__ int moe_tables(Frame& F, int layer) {
    const int wave = F.wave; int lane = lane_id(); asm volatile("" : "+v"(lane)); const int tid = wave * 64 + lane; (void)tid;

    volatile LAS int* tab = (volatile LAS int*)(F.lds + TAB_OFF);
    __syncthreads();
    if (wave == 0) {
        int cnt = 0; if (lane < 32) cnt = (int)__hip_atomic_load(F.ctl + CW_CNT + (layer * 32 + lane) * 32, RLX_AGENT);
        const int nt = (cnt + 255) >> 8;
        int inc = nt;
#pragma unroll
        for (int o = 1; o < 32; o <<= 1) { const int t = __shfl_up(inc, o); if (lane >= o) inc += t; }
        const int base = inc - nt;
        int total = __shfl(inc, 31); if (total > MAXTILES) total = MAXTILES;
        if (lane < 32) { tab[lane] = cnt; tab[32 + lane] = base * 256; for (int t = 0; t < nt; ++t) if (base + t < MAXTILES) tab[128 + base + t] = lane; }
        if (lane == 0) { tab[64] = total * 256; tab[65] = total; }
    }
    __syncthreads();
    return tab[65];
}
__device__ __forceinline__ void dispatch_phase(Frame& F, int layer) {
    const int wave = F.wave; int lane = lane_id(); asm volatile("" : "+v"(lane)); const int tid = wave * 64 + lane; (void)tid;

    (void)moe_tables(F, layer);
    volatile LAS int* tab = (volatile LAS int*)(F.lds + TAB_OFF);
    const unsigned char* XB8 = F.ws + WS_XB8; unsigned char* XG8 = F.ws + WS_R1; const unsigned* TI = (const unsigned*)(F.ws + WS_TI);
    const int gw = F.vcu * NWAVES + wave, NGW = F.G * NWAVES;
#pragma unroll 1
    for (int m = gw; m < T; m += NGW) {
        const v4u t0 = *(const GAS v4u*)(TI + (size_t)m * 8), t1 = *(const GAS v4u*)(TI + (size_t)m * 8 + 4);
        const int r1 = tab[32 + (int)t0.x] + (int)t0.y, r2 = tab[32 + (int)t1.x] + (int)t1.y;
        const GAS v4u* src = (const GAS v4u*)(XB8 + (size_t)m * D) + lane; GAS v4u* d1 = (GAS v4u*)(XG8 + (size_t)r1 * D) + lane; GAS v4u* d2 = (GAS v4u*)(XG8 + (size_t)r2 * D) + lane;
#pragma unroll
        for (int j = 0; j < 2; ++j) { const v4u w = src[64 * j]; d1[64 * j] = w; d2[64 * j] = w; }
    }
}
__device__ __forceinline__ void ln_ffn_phase(Frame& F, int layer, const float* mixg, const float* mixb, const float* lng, const float* lnb, float* out_f, int write_xb  ) {
    const int wave = F.wave; int lane = lane_id(); asm volatile("" : "+v"(lane)); const int tid = wave * 64 + lane; (void)tid;

    (void)moe_tables(F, layer);
    volatile LAS int* tab = (volatile LAS int*)(F.lds + TAB_OFF);
    bf16* XB = (bf16*)(F.ws + WS_XB); bf16* XL = (bf16*)(F.ws + WS_XL); const unsigned char* YR = F.ws + WS_R1 + 160 * MiB; const unsigned* TI = (const unsigned*)(F.ws + WS_TI);
    const int gw = F.vcu * NWAVES + wave, NGW = F.G * NWAVES;
#pragma unroll 1
    for (int m = gw; m < T; m += 2 * NGW) {
        int mr[2]; mr[0] = m; mr[1] = (m + NGW < T) ? m + NGW : m; const bool two = mr[1] != m;
        v4u t0[2], t1[2];
#pragma unroll
        for (int r = 0; r < 2; ++r) { t0[r] = *(const GAS v4u*)(TI + (size_t)mr[r] * 8); t1[r] = *(const GAS v4u*)(TI + (size_t)mr[r] * 8 + 4); }
        f32x4 v[2][8];
#pragma unroll
        for (int r = 0; r < 2; ++r) { const GAS unsigned long long* yr = (const GAS unsigned long long*)((const bf16*)(F.ws + WS_Y) + (size_t)mr[r] * D) + lane;
#pragma unroll
            for (int j = 0; j < 8; ++j) { const unsigned long long yq = yr[64 * j]; const unsigned y0 = (unsigned)yq, y1 = (unsigned)(yq >> 32); v[r][j] = (f32x4){bflo(y0), bfhi(y0), bflo(y1), bfhi(y1)}; } }
#pragma unroll
        for (int r = 0; r < 2; ++r) { float sy = 0.f;
#pragma unroll
            for (int j = 0; j < 8; ++j) sy += (v[r][j].x + v[r][j].y) + (v[r][j].z + v[r][j].w);
            const float my = wave_sum(sy) * (1.0f / D); float qy = 0.f;
#pragma unroll
            for (int j = 0; j < 8; ++j) { v[r][j] = v[r][j] - my; qy += (v[r][j].x * v[r][j].x + v[r][j].y * v[r][j].y) + (v[r][j].z * v[r][j].z + v[r][j].w * v[r][j].w); }
            const float ry = 1.0f / sqrtf(wave_sum(qy) * (1.0f / D) + LN_EPS);
#pragma unroll
            for (int j = 0; j < 8; ++j) { const f32x4 g4 = ((const f32x4*)mixg)[lane + 64 * j], b4 = ((const f32x4*)mixb)[lane + 64 * j]; v[r][j] = v[r][j] * ry * g4 + b4; } }
        float s[2];
#pragma unroll
        for (int r = 0; r < 2; ++r) {
            const unsigned e1 = t0[r].x, sl1 = t0[r].y, wz1 = t0[r].z, e2 = t1[r].x, sl2 = t1[r].y, wz2 = t1[r].z;
            const int r1 = tab[32 + (int)e1] + (int)sl1, r2 = tab[32 + (int)e2] + (int)sl2;
            const float w1 = __uint_as_float(wz1) * (1.0f / Y8_SCALE), w2 = __uint_as_float(wz2) * (1.0f / Y8_SCALE);
            const GAS int* y1 = (const GAS int*)(YR + (size_t)r1 * D) + lane; const GAS int* y2 = (const GAS int*)(YR + (size_t)r2 * D) + lane;
            s[r] = 0.f;
#pragma unroll
            for (int j = 0; j < 8; ++j) { const int a = y1[64 * j], bq = y2[64 * j];
                typedef float f32x2_ __attribute__((ext_vector_type(2)));
                const f32x2_ al = __builtin_amdgcn_cvt_pk_f32_fp8(a, false), ah = __builtin_amdgcn_cvt_pk_f32_fp8(a, true), bl = __builtin_amdgcn_cvt_pk_f32_fp8(bq, false), bh = __builtin_amdgcn_cvt_pk_f32_fp8(bq, true);
                f32x4 mm; mm.x = w1 * al.x + w2 * bl.x; mm.y = w1 * al.y + w2 * bl.y; mm.z = w1 * ah.x + w2 * bh.x; mm.w = w1 * ah.y + w2 * bh.y;
                v[r][j] = v[r][j] * ALPHA + mm; s[r] += (v[r][j].x + v[r][j].y) + (v[r][j].z + v[r][j].w); } }
        float mean[2], s2[2], rstd[2];
#pragma unroll
        for (int r = 0; r < 2; ++r) { mean[r] = wave_sum(s[r]) * (1.0f / D); s2[r] = 0.f;
#pragma unroll
            for (int j = 0; j < 8; ++j) { v[r][j] = v[r][j] - mean[r]; s2[r] += (v[r][j].x * v[r][j].x + v[r][j].y * v[r][j].y) + (v[r][j].z * v[r][j].z + v[r][j].w * v[r][j].w); } }
#pragma unroll
        for (int r = 0; r < 2; ++r) rstd[r] = 1.0f / sqrtf(wave_sum(s2[r]) * (1.0f / D) + LN_EPS);
#pragma unroll
        for (int j = 0; j < 8; ++j) { const f32x4 g4 = ((const f32x4*)lng)[lane + 64 * j], b4 = ((const f32x4*)lnb)[lane + 64 * j];
#pragma unroll
            for (int r = 0; r < 2; ++r) { const f32x4 o = v[r][j] * rstd[r] * g4 + b4;
                if (r == 0 || two) {
                    if (write_xb == 0) ((GAS f32x4*)(out_f + (size_t)mr[r] * D) + lane)[64 * j] = o;
                    else { const unsigned h0 = pk2(o.x, o.y), h1 = pk2(o.z, o.w);
                        ((GAS unsigned long long*)(XB + (size_t)mr[r] * D) + lane)[64 * j] = (unsigned long long)h0 | ((unsigned long long)h1 << 32);
                        const unsigned l0 = pk2(o.x - bflo(h0), o.y - bfhi(h0)), l1 = pk2(o.z - bflo(h1), o.w - bfhi(h1));
                        ((GAS unsigned long long*)(XL + (size_t)mr[r] * D) + lane)[64 * j] = (unsigned long long)l0 | ((unsigned long long)l1 << 32); }
                    if (write_xb == 2) ((GAS unsigned*)(F.ws + WS_XB8 + (size_t)mr[r] * D) + lane)[64 * j] = pk4_fp8(o.x, o.y, o.z, o.w); } } }
    }
}

constexpr int PH_PER_LAYER_ = 9;
struct Args { const float* in[18]; float* out; unsigned char* ws; int ph_lo, ph_hi, use_bar, pad; };

constexpr int PH_PER_LAYER = 9, N_PHASES = 1 + DEPTH * PH_PER_LAYER;
#define IN(k) (lo <= (k) && (k) < hi)
#define SEAM(k) do { if ((k) + 1 < hi) xcd_barrier(bar, F.wave); } while (0)
template <int L> __device__ __forceinline__ void run_layer(Frame& F, const Args& args, const XcdBarrier& bar, const int lo, const int hi) {
    const float* const* in = args.in;
    bf16* XB = (bf16*)(F.ws + WS_XB); float* X = (float*)(F.ws + WS_X); float* Y = (float*)(F.ws + WS_Y); bf16* OB = (bf16*)(F.ws + WS_OB);
    bf16* R1 = (bf16*)(F.ws + WS_R1); bf16* HBUF = (bf16*)(F.ws + WS_H);
        constexpr int l = L; constexpr int base = 1 + l * PH_PER_LAYER, jj = l >> 1; constexpr bool hg = (l & 1) != 0;
        if (!(base < hi && lo < base + PH_PER_LAYER)) return;
#ifndef NO_G0
        if (IN(base + 0)) {
#ifndef NO_G0A
            if constexpr (!hg) {
                pg8::StaticOrder S; S.init((const bf16*)(F.ws + WS_XB8), (const bf16*)(F.ws + WS_WQKV + (size_t)jj * NQKV * D), T, NQKV, D / 2, F.G, (int)blockIdx.x);
                pg8::EpiBf16 E{R1, D, D, (size_t)T * D, 1.0f / W8_SCALE, (float*)(F.ws + WS_KS) + (size_t)jj * (BATCH * NH * NBLK * HD)};
                pg8::gemm_phase<pg8::EpiBf16, pg8::StaticOrder, true, true, true>(F.lds + RING_OFF, D / 2, S, E, F.wave);
            }
#endif
#ifndef NO_G0B
            if constexpr (hg) {
                pg8::StaticOrder S; S.init(XB, (const bf16*)(F.ws + WS_WHIN) + (size_t)jj * NHIN * D, T, NHIN, D, F.G, (int)blockIdx.x);
                pg8::EpiHgrnIn E{R1, (float*)(F.ws + WS_R1 + 64 * MiB), OB  , in[5], in[5] + D, jj, D};
                pg8::gemm_phase<pg8::EpiHgrnIn, pg8::StaticOrder, true, true>(F.lds + RING_OFF, D, S, E, F.wave);
            }
#endif
            SEAM(base + 0);
        }
#endif
        if constexpr (hg) { if (IN(base + 1)) {
 scan_mfma_phase(F);
 SEAM(base + 1); } }
        if (IN(base + 2)) {
#ifndef NO_ATTN
 if constexpr (!hg) {
 attn_mfma_phase(F, jj);
 }
#endif
#ifndef NO_GN
 if constexpr (hg) gatenorm_phase(F, in[4] + (size_t)jj * HD);
#endif
 SEAM(base + 2); }
#ifndef NO_G3
        if (IN(base + 3)) {
            if constexpr (!hg) {
                pg8::StaticOrder S; S.init((const bf16*)(F.ws + WS_OB), (const bf16*)(F.ws + WS_WOM + (size_t)jj * D * D), T, D, D / 2, F.G, (int)blockIdx.x);
                pg8::EpiResB16 E{l == 0 ? in[0] : (const float*)nullptr, XB, (const bf16*)(F.ws + WS_XL), (bf16*)Y, D, ALPHA, 1.0f / (W8_SCALE * O8_SCALE)};
                pg8::gemm_phase<pg8::EpiResB16, pg8::StaticOrder, true, true, true>(F.lds + RING_OFF, D / 2, S, E, F.wave);
            } else {
                pg8::StaticOrder S; S.init(OB, (const bf16*)(F.ws + WS_WOH) + (size_t)jj * D * D, T, D, D, F.G, (int)blockIdx.x);
                pg8::EpiResB16 E{l == 0 ? in[0] : (const float*)nullptr, XB, (const bf16*)(F.ws + WS_XL), (bf16*)Y, D, ALPHA, 1.0f};
                pg8::gemm_phase<pg8::EpiResB16, pg8::StaticOrder, true, true>(F.lds + RING_OFF, D, S, E, F.wave);
            }
            SEAM(base + 3);
        }
#endif
        #ifndef NO_LNR
        if (IN(base + 4)) { ln_route_phase(F, l, in[7] + (size_t)l * D, in[8] + (size_t)l * D, in[9] + (size_t)l * D * 4, in[10] + l * 4, in[11] + (size_t)l * 4 * D * 8, in[12] + l * 32); SEAM(base + 4); }
#endif
        if (IN(base + 5)) { dispatch_phase(F, l); SEAM(base + 5); }
#ifndef NO_G6
        if (IN(base + 6)) {
            const int ntl = moe_tables(F, l);
            pg8::MoeOrder S{R1, (const bf16*)(F.ws + WS_W1 + (size_t)l * 32 * 1024 * D), D / 2, 4, (size_t)1024 * D, ntl, F.G, F.vcu, (const LAS int*)(F.lds + TAB_OFF) + 128};
            pg8::EpiMoe1 E{(unsigned char*)HBUF, DEXP, H8_SCALE, 1.0f / W8_SCALE};
            pg8::gemm_phase<pg8::EpiMoe1, pg8::MoeOrder, true, true, true>(F.lds + RING_OFF, D / 2, S, E, F.wave);
            {
                const int total = ntl * 4, rem = total % F.G;
                if (F.vcu >= rem) conv_tiles<1>(F, in, F.vcu - rem, F.G - rem, CV_NDEF, l, F.wave * 64 + lane_id());
            }
            SEAM(base + 6);
        }
#endif
#ifndef NO_G7
        if (IN(base + 7)) {
            const int ntl = moe_tables(F, l);
            pg8::MoeOrder S{HBUF, (const bf16*)(F.ws + WS_W2 + (size_t)l * 32 * D * DEXP), DEXP / 2, 8, (size_t)D * DEXP, ntl, F.G, F.vcu, (const LAS int*)(F.lds + TAB_OFF) + 128};
            pg8::EpiF8 E{F.ws + WS_R1 + 160 * MiB, D, Y8_SCALE / (W8_SCALE * H8_SCALE)};
            pg8::gemm_phase<pg8::EpiF8, pg8::MoeOrder, true, true, true>(F.lds + RING_OFF, DEXP / 2, S, E, F.wave);
            SEAM(base + 7);
        }
#endif
        #ifndef NO_LNF
        if (IN(base + 8)) { ln_ffn_phase(F, l, in[7] + (size_t)l * D, in[8] + (size_t)l * D, in[16] + (size_t)l * D, in[17] + (size_t)l * D, args.out, l == DEPTH - 1 ? 0 : (hg ? 2 : 1)); SEAM(base + 8); }
#endif
    }
__global__ void __launch_bounds__(NTHR, 2) mk_fwd(Args args) {
    extern __shared__ __attribute__((aligned(16))) unsigned char lds[];
    Frame F;
    F.lds = (LAS unsigned char*)lds;
    F.MISC = (volatile LAS unsigned*)(F.lds + MISC_OFF);
    F.wave = __builtin_amdgcn_readfirstlane((int)(threadIdx.x >> 6));
    F.G = gridDim.x; { const int bx = blockIdx.x; F.vcu = (F.G % 8 == 0) ? (bx % 8) * (F.G / 8) + bx / 8 : bx; }
    F.ws = args.ws; F.ctl = (gu32*)(args.ws + WS_CTL);
    for (int u = F.wave * 64 + lane_id(); u < (LDS_BYTES - LDSCTL_OFF) / 4; u += NTHR) ((LAS unsigned*)(F.lds + LDSCTL_OFF))[u] = 0u;
    __syncthreads();
    XcdBarrier bar; bar.bar = (unsigned*)(F.ctl + CW_BAR); bar.x = 0; bar.st = nullptr;
    if (args.use_bar) bar = xcd_barrier_post((unsigned*)(F.ctl + CW_BAR), F.MISC + 8, F.wave == 0 && lane_id() == 0);
    const int lo = args.ph_lo, hi = args.ph_hi;
    const float* const* in = args.in;
    bf16* XB = (bf16*)(F.ws + WS_XB); float* X = (float*)(F.ws + WS_X); float* Y = (float*)(F.ws + WS_Y); bf16* OB = (bf16*)(F.ws + WS_OB);
    bf16* R1 = (bf16*)(F.ws + WS_R1); bf16* HBUF = (bf16*)(F.ws + WS_H);

    #ifndef NO_P0
    if (IN(0)) { p0_prologue(F, in); SEAM(0); }
#endif

    run_layer<0>(F, args, bar, lo, hi); run_layer<1>(F, args, bar, lo, hi); run_layer<2>(F, args, bar, lo, hi); run_layer<3>(F, args, bar, lo, hi);
#undef IN
#undef SEAM
}

#ifndef MK_N_LAUNCHES
#define MK_N_LAUNCHES 1
#endif
extern "C" void kernel_launch(void* const* d_in, const int* in_sizes, int n_in, void* d_out, int out_size, void* d_ws, size_t ws_size, hipStream_t stream) {
    static int grid = 0;
    if (grid == 0) {
        if (n_in != 18 || in_sizes[0] != T * D || out_size != T * D || ws_size < WS_END) { fprintf(stderr, "kernel_launch: unexpected shapes (n_in %d, in0 %d, out %d, ws %zu); nothing launched\n", n_in, n_in > 0 ? in_sizes[0] : -1, out_size, ws_size); grid = -1; return; }
        int dev = 0, cus = 0, per_cu = 0;
        if (hipGetDevice(&dev) != hipSuccess || hipDeviceGetAttribute(&cus, hipDeviceAttributeMultiprocessorCount, dev) != hipSuccess) { fprintf(stderr, "kernel_launch: device query failed\n"); grid = -1; return; }
        if (hipFuncSetAttribute((const void*)mk_fwd, hipFuncAttributeMaxDynamicSharedMemorySize, LDS_BYTES) != hipSuccess) { fprintf(stderr, "kernel_launch: hipFuncSetAttribute failed\n"); grid = -1; return; }
        if (hipOccupancyMaxActiveBlocksPerMultiprocessor(&per_cu, (const void*)mk_fwd, NTHR, LDS_BYTES) != hipSuccess || per_cu < 1) fprintf(stderr, "kernel_launch: occupancy query reports %d\n", per_cu);
        (void)hipGetLastError();
        grid = cus;
    }
    if (grid < 0) return;
    if (hipMemsetAsync((char*)d_ws + WS_CTL, 0, CTL_ZERO_BYTES, stream) != hipSuccess) { fprintf(stderr, "kernel_launch: memset failed\n"); return; }
    Args a{};
    for (int i = 0; i < 18; ++i) a.in[i] = (const float*)d_in[i];
    a.out = (float*)d_out; a.ws = (unsigned char*)d_ws; a.pad = 0;
#if MK_N_LAUNCHES == 1
    a.ph_lo = 0; a.ph_hi = N_PHASES; a.use_bar = 1;
    hipLaunchKernelGGL(mk_fwd, dim3(grid), dim3(NTHR), LDS_BYTES, stream, a);
#else
    for (int p = 0; p < N_PHASES; ++p) { a.ph_lo = p; a.ph_hi = p + 1; a.use_bar = 0; hipLaunchKernelGGL(mk_fwd, dim3(grid), dim3(NTHR), LDS_BYTES, stream, a); }
#endif
    const hipError_t le = hipPeekAtLastError();
    if (le != hipSuccess) fprintf(stderr, "kernel_launch: launch failed: %s\n", hipGetErrorName(le));
}
```
